# Optimizing an MI355X kernel written in HIP

```python
import jax, jax.numpy as jnp
from jax import lax
import numpy as np

D_MODEL = 2048
BATCH = 8
SEQ = 2048
DEPTH = 2

GRID_W = 64
CTX_LEN = 256
N_MIXERS = 2
N_HGRN_LAYERS = (DEPTH + 1) // 2
N_CONV_LAYERS = DEPTH // 2
HGRN_EXPAND = 128
HGRN_HEADS = D_MODEL // HGRN_EXPAND
HGRN_HEAD_V = D_MODEL // HGRN_HEADS
HGRN_CHUNK = 64
CONV_WIDTH = 31
CONV_HALF = D_MODEL // 2
MOE_GROUPS = 8
MOE_PER_GROUP = 8
MOE_EXPERTS = MOE_GROUPS * MOE_PER_GROUP
MOE_TOPK = 2
MOE_HIDDEN = D_MODEL // 4
MOE_BLOCK = 256
EPS = 1e-6

kernel_name = 'hybrid_hgrn2_conformer_hmoe_dit'


def rmsnorm(x, g):
    xf = x.astype(jnp.float32)
    y = xf * lax.rsqrt(jnp.mean(xf * xf, axis=-1, keepdims=True) + EPS)
    return (y * g.astype(jnp.float32)).astype(x.dtype)


def layernorm(x, g, b):
    xf = x.astype(jnp.float32)
    mu = jnp.mean(xf, axis=-1, keepdims=True)
    xc = xf - mu
    y = xc * lax.rsqrt(jnp.mean(xc * xc, axis=-1, keepdims=True) + EPS)
    return (y * g.astype(jnp.float32) + b.astype(jnp.float32)).astype(x.dtype)


def modulate(h, shift, scale):
    return h * (1.0 + scale) + shift


def _forget(z, lb):
    f = lb + (1.0 - lb) * jax.nn.sigmoid(z.astype(jnp.float32))
    return jnp.log(f), 1.0 - f


def _chunked_gated_scan(q, k, v, log_f, s0):
    b_, t_, h_, _ = q.shape
    vd = v.shape[-1]
    nc = t_ // HGRN_CHUNK

    def to_chunks(a):
        a = a.astype(jnp.float32).reshape(b_, nc, HGRN_CHUNK, h_, a.shape[-1])
        return a.transpose(1, 0, 3, 2, 4)

    tril = jnp.tril(jnp.ones((HGRN_CHUNK, HGRN_CHUNK), dtype=bool))[:, :, None]

    def step(s, inp):
        qc, kc, vc, gc = inp
        bcum = jnp.cumsum(gc, axis=2)
        o_inter = jnp.einsum('bhck,bhkv->bhcv', qc * jnp.exp(bcum), s)
        diff = bcum[:, :, :, None, :] - bcum[:, :, None, :, :]
        decay = jnp.where(tril, jnp.exp(jnp.where(tril, diff, 0.0)), 0.0)
        scores = jnp.einsum('bhtk,bhtsk,bhsk->bhts', qc, decay, kc)
        o_intra = jnp.einsum('bhts,bhsv->bhtv', scores, vc)
        blast = bcum[:, :, -1:, :]
        s_new = jnp.exp(blast[:, :, 0, :])[..., None] * s + jnp.einsum(
            'bhck,bhcv->bhkv', kc * jnp.exp(blast - bcum), vc)
        return s_new, o_inter + o_intra

    s_fin, o = lax.scan(step, s0, (to_chunks(q), to_chunks(k), to_chunks(v), to_chunks(log_f)))
    o = o.transpose(1, 0, 3, 2, 4).reshape(b_, t_, h_, vd)
    return o, s_fin


def hgrn2_mixer(a_lat, a_ctx, w_in, lb, onorm_g, w_out, ctx_out):
    lb_fw = lb[0].reshape(HGRN_HEADS, HGRN_EXPAND)
    lb_bw = lb[1].reshape(HGRN_HEADS, HGRN_EXPAND)

    def project(a):
        b_, t_, _ = a.shape
        q, i_in, z_fw, z_bw, g = jnp.split(a @ w_in, 5, axis=-1)
        hk = lambda t: t.reshape(b_, t_, HGRN_HEADS, HGRN_EXPAND)
        lf_fw, k_fw = _forget(hk(z_fw), lb_fw)
        lf_bw, k_bw = _forget(hk(z_bw), lb_bw)
        v = i_in.reshape(b_, t_, HGRN_HEADS, HGRN_HEAD_V)
        return hk(jax.nn.silu(q)), v, lf_fw, k_fw, lf_bw, k_bw, g

    def bidir(p, s_fw, s_bw):
        q, v, lf_fw, k_fw, lf_bw, k_bw, _ = p
        flip = lambda t: t[:, ::-1]
        o_fw, s_fw_new = _chunked_gated_scan(q, k_fw, v, lf_fw, s_fw)
        o_bw, s_bw_new = _chunked_gated_scan(flip(q), flip(k_bw), flip(v), flip(lf_bw), s_bw)
        return o_fw + flip(o_bw), s_fw_new, s_bw_new

    def readout(o, g):
        b_, t_, _ = g.shape
        o = rmsnorm(o, onorm_g).astype(g.dtype)
        o = o * jax.nn.silu(g).reshape(b_, t_, HGRN_HEADS, HGRN_HEAD_V)
        return o.reshape(b_, t_, D_MODEL) @ w_out

    p_ctx = project(a_ctx)
    p_lat = project(a_lat)
    s0 = jnp.zeros((a_lat.shape[0], HGRN_HEADS, HGRN_EXPAND, HGRN_HEAD_V), jnp.float32)
    o_ctx, s_fw, s_bw = bidir(p_ctx, s0, s0)
    o_lat, _, _ = bidir(p_lat, s_fw, s_bw)
    y_lat = readout(o_lat, p_lat[-1])
    y_ctx = readout(o_ctx, p_ctx[-1]) if ctx_out else None
    return y_lat, y_ctx


def _dwconv_1d(u, w):
    pad = CONV_WIDTH // 2
    return lax.conv_general_dilated(
        u, w[:, None, :].astype(u.dtype), window_strides=(1,), padding=[(pad, pad)],
        dimension_numbers=('NWC', 'WIO', 'NWC'), feature_group_count=u.shape[-1])


def conformer_conv(a, w_pw1, w_dw, b_dw, ln_g, ln_b, w_pw2, on_grid):
    val, gate = jnp.split(a @ w_pw1, 2, axis=-1)
    u = val * jax.nn.sigmoid(gate)
    if on_grid:
        b_, t_, d = u.shape
        rows = t_ // GRID_W
        ug = u.reshape(b_, rows, GRID_W, d)
        uh = ug[..., :CONV_HALF].reshape(b_ * rows, GRID_W, CONV_HALF)
        uh = _dwconv_1d(uh, w_dw[:, :CONV_HALF]).reshape(b_, rows, GRID_W, CONV_HALF)
        uv = ug[..., CONV_HALF:].transpose(0, 2, 1, 3).reshape(b_ * GRID_W, rows, d - CONV_HALF)
        uv = _dwconv_1d(uv, w_dw[:, CONV_HALF:]).reshape(b_, GRID_W, rows, d - CONV_HALF).transpose(0, 2, 1, 3)
        u = jnp.concatenate([uh, uv], axis=-1).reshape(b_, t_, d)
    else:
        u = _dwconv_1d(u, w_dw)
    u = jax.nn.silu(layernorm(u + b_dw, ln_g, ln_b))
    return u @ w_pw2


def hier_moe(h, w_r1, b_r1, w_r2, b_r2, w_gate, w_up, w_down):
    n, d = h.shape
    f32 = jnp.float32
    lg1 = (h @ w_r1).astype(f32) + b_r1.astype(f32)
    p1 = jax.nn.softmax(lg1, axis=-1)
    grp = jnp.argmax(lg1, axis=-1)
    pg = jnp.take_along_axis(p1, grp[:, None], axis=1)
    lg2 = jnp.einsum('nd,gde->nge', h, w_r2).astype(f32) + b_r2.astype(f32)
    lg2 = jnp.take_along_axis(lg2, grp[:, None, None], axis=1)[:, 0]
    top_p, top_i = lax.top_k(jax.nn.softmax(lg2, axis=-1), MOE_TOPK)
    gate = pg * top_p / jnp.sum(top_p, axis=-1, keepdims=True)
    expert = grp[:, None].astype(jnp.int32) * MOE_PER_GROUP + top_i.astype(jnp.int32)

    e_flat = expert.reshape(-1)
    w_flat = gate.reshape(-1)
    tok_flat = jnp.repeat(jnp.arange(n, dtype=jnp.int32), MOE_TOPK)
    order = jnp.argsort(e_flat)
    e_s, tok_s, w_s = e_flat[order], tok_flat[order], w_flat[order]
    counts = jnp.zeros((MOE_EXPERTS,), jnp.int32).at[e_flat].add(1)
    padded = (counts + MOE_BLOCK - 1) // MOE_BLOCK * MOE_BLOCK
    pad_end = jnp.cumsum(padded)
    pad_start = pad_end - padded
    raw_start = jnp.cumsum(counts) - counts
    pos = pad_start[e_s] + jnp.arange(n * MOE_TOPK, dtype=jnp.int32) - raw_start[e_s]
    n_blocks = -(-(n * MOE_TOPK) // MOE_BLOCK) + MOE_EXPERTS
    slot_tok = jnp.full((n_blocks * MOE_BLOCK,), n, jnp.int32).at[pos].set(tok_s)
    slot_w = jnp.zeros((n_blocks * MOE_BLOCK,), f32).at[pos].set(w_s)
    blk_start = jnp.arange(n_blocks, dtype=jnp.int32) * MOE_BLOCK
    blk_e = jnp.minimum(jnp.searchsorted(pad_end, blk_start, side='right'), MOE_EXPERTS - 1)
    h_pad = jnp.concatenate([h, jnp.zeros((1, d), h.dtype)], axis=0)

    def run_block(args):
        e, toks = args
        xb = h_pad[toks]
        return (jax.nn.silu(xb @ w_gate[e]) * (xb @ w_up[e])) @ w_down[e]

    out = lax.map(run_block, (blk_e, slot_tok.reshape(n_blocks, MOE_BLOCK)))
    out = out.reshape(-1, d) * slot_w[:, None].astype(h.dtype)
    y = jnp.zeros((n + 1, d), h.dtype).at[slot_tok].add(out)
    return y[:n]


def setup_inputs(seed: int = 0) -> dict:
    key = jax.random.key(seed)
    ks = jax.random.split(key, 28)
    f32 = jnp.float32
    D = D_MODEL
    nrm = lambda k, shape, s: jax.random.normal(k, shape, f32) * s
    return {
        'x': nrm(ks[0], (BATCH, SEQ, D), 1.0),
        'c': nrm(ks[1], (BATCH, D), 1.0),
        'ctx': nrm(ks[2], (BATCH, CTX_LEN, D), 1.0),
        'c_ctx': nrm(ks[3], (D,), 1.0),
        'ada_w': nrm(ks[4], (DEPTH, D, 6 * D), 0.5 * D ** -0.5),
        'ada_b': nrm(ks[5], (DEPTH, 6 * D), 0.02),
        'norm1_g': 1.0 + nrm(ks[6], (DEPTH, D), 0.02),
        'norm2_g': 1.0 + nrm(ks[7], (DEPTH, D), 0.02),
        'hgrn_w_in': nrm(ks[8], (N_HGRN_LAYERS, D, 5 * D), D ** -0.5),
        'hgrn_lb': nrm(ks[9], (2, DEPTH + 1, D), 0.1),
        'hgrn_onorm_g': 1.0 + nrm(ks[10], (N_HGRN_LAYERS, HGRN_HEAD_V), 0.02),
        'hgrn_w_out': nrm(ks[11], (N_HGRN_LAYERS, D, D), D ** -0.5),
        'conv_w_pw1': nrm(ks[12], (N_CONV_LAYERS, D, 2 * D), D ** -0.5),
        'conv_w_dw': nrm(ks[13], (N_CONV_LAYERS, CONV_WIDTH, D), CONV_WIDTH ** -0.5),
        'conv_b_dw': nrm(ks[14], (N_CONV_LAYERS, D), 0.02),
        'conv_ln_g': 1.0 + nrm(ks[15], (N_CONV_LAYERS, D), 0.02),
        'conv_ln_b': nrm(ks[16], (N_CONV_LAYERS, D), 0.02),
        'conv_w_pw2': nrm(ks[17], (N_CONV_LAYERS, D, D), D ** -0.5),
        'moe_w_r1': nrm(ks[18], (DEPTH, D, MOE_GROUPS), D ** -0.5),
        'moe_b_r1': nrm(ks[19], (DEPTH, MOE_GROUPS), 0.01),
        'moe_w_r2': nrm(ks[20], (DEPTH, MOE_GROUPS, D, MOE_PER_GROUP), D ** -0.5),
        'moe_b_r2': nrm(ks[21], (DEPTH, MOE_GROUPS, MOE_PER_GROUP), 0.01),
        'moe_w_gate': nrm(ks[22], (DEPTH, MOE_EXPERTS, D, MOE_HIDDEN), D ** -0.5),
        'moe_w_up': nrm(ks[23], (DEPTH, MOE_EXPERTS, D, MOE_HIDDEN), D ** -0.5),
        'moe_w_down': nrm(ks[24], (DEPTH, MOE_EXPERTS, MOE_HIDDEN, D), MOE_HIDDEN ** -0.5),
        'final_g': 1.0 + nrm(ks[25], (D,), 0.02),
    }


def reference(x, c, ctx, c_ctx, ada_w, ada_b, norm1_g, norm2_g, hgrn_w_in, hgrn_lb, hgrn_onorm_g,
              hgrn_w_out, conv_w_pw1, conv_w_dw, conv_b_dw, conv_ln_g, conv_ln_b, conv_w_pw2,
              moe_w_r1, moe_b_r1, moe_w_r2, moe_b_r2, moe_w_gate, moe_w_up, moe_w_down, final_g):
    bsz, seq, d = x.shape
    lb_all = jnp.cumsum(jax.nn.softmax(hgrn_lb.astype(jnp.float32), axis=1), axis=1)
    s_c = jax.nn.silu(c)
    s_cc = jax.nn.silu(c_ctx)
    reads_ctx = [i % N_MIXERS == 0 for i in range(DEPTH)]
    h, hc = x, ctx
    for i in range(DEPTH):
        j = i // N_MIXERS
        ctx_later = any(reads_ctx[i + 1:])
        mod = jnp.split((s_c @ ada_w[i] + ada_b[i])[:, None, :], 6, axis=-1)
        mod_c = jnp.split((s_cc @ ada_w[i] + ada_b[i])[None, None, :], 6, axis=-1)
        a = modulate(rmsnorm(h, norm1_g[i]), mod[0], mod[1])
        ac = None
        if reads_ctx[i] or ctx_later:
            ac = modulate(rmsnorm(hc, norm1_g[i]), mod_c[0], mod_c[1])
        if i % N_MIXERS == 0:
            y, yc = hgrn2_mixer(a, ac, hgrn_w_in[j], lb_all[:, i], hgrn_onorm_g[j], hgrn_w_out[j], ctx_later)
        else:
            y = conformer_conv(a, conv_w_pw1[j], conv_w_dw[j], conv_b_dw[j], conv_ln_g[j], conv_ln_b[j],
                               conv_w_pw2[j], True)
            yc = None
            if ctx_later:
                yc = conformer_conv(ac, conv_w_pw1[j], conv_w_dw[j], conv_b_dw[j], conv_ln_g[j],
                                    conv_ln_b[j], conv_w_pw2[j], False)
        h = h + mod[2] * y
        b = modulate(rmsnorm(h, norm2_g[i]), mod[3], mod[4])
        moe_args = (moe_w_r1[i], moe_b_r1[i], moe_w_r2[i], moe_b_r2[i], moe_w_gate[i], moe_w_up[i], moe_w_down[i])
        if ctx_later:
            hc = hc + mod_c[2] * yc
            bc = modulate(rmsnorm(hc, norm2_g[i]), mod_c[3], mod_c[4])
            n_lat = bsz * seq
            z = hier_moe(jnp.concatenate([b.reshape(-1, d), bc.reshape(-1, d)], axis=0), *moe_args)
            h = h + mod[5] * z[:n_lat].reshape(bsz, seq, d)
            hc = hc + mod_c[5] * z[n_lat:].reshape(hc.shape)
        else:
            z = hier_moe(b.reshape(-1, d), *moe_args)
            h = h + mod[5] * z.reshape(bsz, seq, d)
    return rmsnorm(h, final_g)
```

```cpp
#include <hip/hip_runtime.h>
#include <cstdio>
#include <cstdint>

#ifndef MK_MULTI
#define MK_MULTI 0
#endif
#ifndef GOLD_GEMM
#define GOLD_GEMM 0
#endif
#ifndef GOLD_SCAN
#define GOLD_SCAN 0
#endif

#define LAS __attribute__((address_space(3)))
typedef unsigned short bf16_t;
typedef _Float16 f16_t;
typedef short bf16x8 __attribute__((ext_vector_type(8)));
typedef float f32x4 __attribute__((ext_vector_type(4)));
typedef float f32x2 __attribute__((ext_vector_type(2)));
typedef unsigned u32x4 __attribute__((ext_vector_type(4)));
typedef unsigned u32x2 __attribute__((ext_vector_type(2)));

constexpr int D = 2048, NBATCH = 8, SEQ = 2048, NT = NBATCH * SEQ, CTXL = 256, NC = NBATCH * CTXL, NR = NT + NC;
constexpr int NHEAD = 16, HK = 128;
constexpr int NEXP = 64, MHID = 512, MAXBLK = 192, MAXSLOT = MAXBLK * 256;
constexpr float EPS = 1e-6f;
constexpr int NTHREADS = 512;

constexpr size_t MiB = 1u << 20;
constexpr size_t WS_CTL = 0, CTL_BYTES = 1 * MiB;
constexpr size_t WS_MOD = 1 * MiB;
constexpr size_t WS_LB = 2 * MiB;
constexpr size_t WS_ROUTE = 3 * MiB;
constexpr size_t WS_MODP = 5 * MiB;
constexpr size_t WS_WIN = 32 * MiB;
constexpr size_t WS_WOUT = 72 * MiB;
constexpr size_t WS_WPW1 = 80 * MiB;
constexpr size_t WS_WPW2 = 96 * MiB;
constexpr size_t WS_WGU = 104 * MiB;
constexpr size_t WS_WD = 616 * MiB;
constexpr size_t WS_H = 872 * MiB;
constexpr size_t WS_A = 1000 * MiB;
constexpr size_t WS_QS = 1072 * MiB, WS_GS = 1136 * MiB, WS_VV = 1200 * MiB, WS_KF = 1272 * MiB, WS_KB = 1344 * MiB, WS_OFW = 1416 * MiB, WS_OBW = 1480 * MiB;
constexpr size_t WS_XG = 1072 * MiB;
constexpr size_t WS_HB = 1264 * MiB;
constexpr size_t WS_ZB = 1312 * MiB;
constexpr size_t WS_UB = 1440 * MiB, WS_CV = 1504 * MiB;
constexpr size_t WS_RWH = 1568 * MiB, WS_RWL = 1574 * MiB;
constexpr size_t WS_RBIAS = 2 * MiB + 65536;
constexpr size_t WS_END = 1582 * MiB;
constexpr int CW_BAR = 4096;
constexpr int CW_CNT = 16384;
__host__ __device__ constexpr int cw_cnt(int l, int which, int e) { return CW_CNT + (((l * 2 + which) * 64 + e) * 64); }

constexpr int LDS_TAB = 131072;
constexpr int LDS_MISC = 131072 + 4096;
constexpr int LDS_BYTES = 147456;

__device__ __forceinline__ float wave_sum(float v) {
#pragma unroll
    for (int o = 1; o < 64; o <<= 1) v += __shfl_xor(v, o);
    return v;
}
__device__ __forceinline__ unsigned f2bf(float f) { unsigned u = __builtin_bit_cast(unsigned, f); return (u + 0x7fffu + ((u >> 16) & 1u)) >> 16; }
typedef __bf16 bf16x2_t __attribute__((ext_vector_type(2)));
__device__ __forceinline__ unsigned pk2(float lo, float hi) { const bf16x2_t r = __builtin_convertvector((f32x2){lo, hi}, bf16x2_t); return __builtin_bit_cast(unsigned, r); }
__device__ __forceinline__ float bflo(unsigned w) { return __builtin_bit_cast(float, w << 16); }
__device__ __forceinline__ float bfhi(unsigned w) { return __builtin_bit_cast(float, w & 0xffff0000u); }
__device__ __forceinline__ float bf2f(bf16_t b) { return __builtin_bit_cast(float, (unsigned)b << 16); }
__device__ __forceinline__ float sigm(float x) { return __builtin_amdgcn_rcpf(1.f + __builtin_amdgcn_exp2f(-1.44269504f * x)); }
__device__ __forceinline__ float silu(float x) { return x * __builtin_amdgcn_rcpf(1.f + __builtin_amdgcn_exp2f(-1.44269504f * x)); }

#define XB_TMO      128
#define XB_XCNT(j)  (256  + 64 * (j))
#define XB_XSUB(j)  (1280 + 64 * (j))
#define XB_XGEN(j)  (2304 + 64 * (j))
#define XB_TOP      3328
#define XB_TOPGEN   3392
#define XCD_BAR_WORDS 3456
#define XB_SPIN_CAP (1u << 18)
__device__ __forceinline__ unsigned xb_ld(unsigned* p)              { return __hip_atomic_load(p, __ATOMIC_RELAXED, __HIP_MEMORY_SCOPE_AGENT); }
__device__ __forceinline__ unsigned xb_add(unsigned* p, unsigned v) { return __hip_atomic_fetch_add(p, v, __ATOMIC_RELAXED, __HIP_MEMORY_SCOPE_AGENT); }
__device__ __forceinline__ unsigned xb_xcc_id() { return (unsigned)__builtin_amdgcn_s_getreg((3 << 11) | 20) & 0xFu; }
#define XB_SPIN(cond, bar) do { unsigned _sp = 0; while (cond) { __builtin_amdgcn_s_sleep(1); \
    if ((++_sp & 255u) == 0u) { if (xb_ld(&(bar)[XB_TMO])) break; if (_sp > XB_SPIN_CAP) { atomicAdd(&(bar)[XB_TMO], 1u); break; } } } } while (0)
struct XcdBarrier { unsigned* bar; unsigned x; volatile LAS unsigned* st; };
__device__ __forceinline__ XcdBarrier xcd_barrier_post(unsigned* bar, volatile LAS unsigned* st) {
    XcdBarrier b; b.bar = bar; b.x = xb_xcc_id(); b.st = st;
    if (threadIdx.x == 0) (void)xb_add(&bar[XB_XCNT(b.x)], 1u);
    return b;
}
__device__ __forceinline__ void xcd_barrier_complete(unsigned* bar, unsigned x, unsigned& nloc, unsigned& nx) {
    const unsigned G = gridDim.x * gridDim.y * gridDim.z;
    unsigned sum, cnt, mine, sp = 0u;
    for (;;) {
        sum = 0u; cnt = 0u; mine = 0u;
#pragma unroll
        for (unsigned j = 0; j < 16; ++j) { const unsigned c = xb_ld(&bar[XB_XCNT(j)]); sum += c; cnt += (c > 0u) ? 1u : 0u; mine = (j == x) ? c : mine; }
        if (sum == G) break;
        __builtin_amdgcn_s_sleep(1);
        if ((++sp & 255u) == 0u) { if (xb_ld(&bar[XB_TMO])) break; if (sp > XB_SPIN_CAP) { atomicAdd(&bar[XB_TMO], 1u); break; } }
    }
    nloc = mine > 0u ? mine : 1u; nx = cnt > 0u ? cnt : 1u;
}
__device__ __forceinline__ void xcd_barrier(const XcdBarrier& b) {
    asm volatile("s_waitcnt vmcnt(0)" ::: "memory");
    __syncthreads();
    if (threadIdx.x == 0) {
        unsigned* bar = b.bar;
        __builtin_amdgcn_s_waitcnt(0);
        unsigned nloc = b.st[0], nx = b.st[1];
        if (nloc == 0u) { xcd_barrier_complete(bar, b.x, nloc, nx); b.st[0] = nloc; b.st[1] = nx; }
        const unsigned old = xb_add(&bar[XB_XSUB(b.x)], 1u);
        const unsigned gen = old / nloc;
        if (old + 1u == (gen + 1u) * nloc) {
            __builtin_amdgcn_fence(__ATOMIC_RELEASE, "agent");
            asm volatile("s_waitcnt vmcnt(0)" ::: "memory");
            const unsigned og = xb_add(&bar[XB_TOP], 1u);
            const unsigned tg = og / nx;
            if (og + 1u == (tg + 1u) * nx) xb_add(&bar[XB_TOPGEN], 1u);
            else XB_SPIN(xb_ld(&bar[XB_TOPGEN]) == tg, bar);
            __builtin_amdgcn_fence(__ATOMIC_ACQUIRE, "agent");
            xb_add(&bar[XB_XGEN(b.x)], 1u);
            asm volatile("s_waitcnt vmcnt(0)" ::: "memory");
        } else {
            XB_SPIN(xb_ld(&bar[XB_XGEN(b.x)]) == gen, bar);
            __builtin_amdgcn_fence(__ATOMIC_ACQUIRE, "agent");
            asm volatile("s_waitcnt vmcnt(0)" ::: "memory");
        }
    }
    __syncthreads();
}

struct Ctx {
    LAS unsigned char* lds;
    int tid, lane, wave, bid, nb, vc;
    const float *x, *c, *ctxx, *c_ctx, *ada_w, *ada_b, *n1g, *n2g, *w_in, *hlb, *onorm, *w_out, *pw1, *wdw, *bdw, *lng, *lnb, *pw2, *wr1, *br1, *wr2, *br2, *wg, *wu, *wd, *fing;
    float* out;
    unsigned* ctl; float* mod; float* lbt; bf16_t *rwh, *rwl; float* rbias; int* eid; float* gwt; int* slot_dst; float* slot_w; float* modp;
    bf16_t *Win, *Wout, *Wpw1, *Wpw2, *Wgu, *Wd;
    bf16_t* H; bf16_t* A; bf16_t *qs, *gs, *vv; f16_t *kf, *kb; bf16_t *ofw, *obw; bf16_t *Xg, *Hb, *zb, *ub, *cvb;
};
__device__ __forceinline__ const float* modptr(const Ctx& C, int l, int r, int chunk) { return C.mod + ((size_t)(l * 9 + r) * 6 + chunk) * D; }


#ifndef DIAG_CK
#define DIAG_CK 0
#endif
#if DIAG_CK
constexpr int CW_CK = 40000;
constexpr size_t WS_STICKY = 1580 * MiB;
__device__ __forceinline__ void cksum(const Ctx& C, int slot, const void* p, size_t nbytes) {
    const u32x4* q = (const u32x4*)p; const size_t n = nbytes / 16; unsigned acc = 0;
    for (size_t i = (size_t)C.bid * NTHREADS + C.tid; i < n; i += (size_t)C.nb * NTHREADS) { const u32x4 v = q[i]; acc += v.x + v.y * 3u + v.z * 5u + v.w * 7u; }
#pragma unroll
    for (int o = 1; o < 64; o <<= 1) acc += __shfl_xor(acc, o);
    if (C.lane == 0) atomicAdd(C.ctl + CW_CK + slot, acc);
}
#endif
struct Unit { int pm, pn, pj; };
constexpr int BM = 256, BK = 64, HALF = 128, HTB = HALF * BK * 2, NXCD = 8, WGM = 8;
__host__ __device__ __forceinline__ int lds_byte(int r, int c) { const int st = (r >> 4) * 2 + (c >> 5), rr = r & 15, cc = c & 31, ob = rr * 64 + cc * 2; return st * 1024 + (ob ^ (((ob >> 9) & 1) << 5)); }
__host__ __device__ __forceinline__ void stage_rc(int b, int& R, int& C) { const int st = b / 1024, sb = b % 1024, swz = sb ^ (((sb >> 9) & 1) << 5); R = (st >> 1) * 16 + swz / 64; C = (st & 1) * 32 + (swz % 64) / 2; }
__host__ __device__ __forceinline__ int perm32(int rho) { const int n = rho >> 4, i = rho & 15; return 8 * (i >> 2) + 4 * n + (i & 3); }

__device__ __forceinline__ void static_tile(long L, int nM, int nN, int& pm, int& pn) {
    const int nwg = nM * nN; int wgid = (int)L;
    { const int q = nwg / NXCD, r = nwg % NXCD, xcd = wgid % NXCD, off = wgid / NXCD; wgid = (xcd < r ? xcd * (q + 1) : r * (q + 1) + (xcd - r) * q) + off; }
    const int nig = WGM * nN, gid = wgid / nig, fm = gid * WGM, gsz = (nM - fm) < WGM ? (nM - fm) : WGM;
    pm = fm + ((wgid % nig) % gsz); pn = (wgid % nig) / gsz;
}
struct DenseSched {
    int nM, nN, G, c, r0 = 0, r1 = 1 << 20;
    __device__ __forceinline__ bool next(int i, Unit& u) const {
        if (r0 + i >= r1) return false;
        const long L = (long)(r0 + i) * G + c; if (L >= (long)nM * nN) return false;
        static_tile(L, nM, nN, u.pm, u.pn); u.pj = u.pn; return true;
    }
};
struct ProjSched {
    int G, c, r0, r1;
    __device__ __forceinline__ bool next(int i, Unit& u) const {
        if (r0 + i >= r1) return false;
        const long L = (long)(r0 + i) * G + c;
        if (L < 2560) { static_tile(L, 64, 40, u.pm, u.pn); u.pj = u.pn; return true; }
        const int r = (int)(L - 2560); if (r >= 192) return false;
        u.pm = 64 + (r & 7); u.pn = 8 + (r >> 3); u.pj = u.pn; return true;
    }
};
struct MoeSched {
    const LAS int* tab; int nN, G, vc, wbase;
    __device__ __forceinline__ bool next(int i, Unit& u) const {
        const int L = i * G + vc; const int nblk = tab[0]; if (L >= nblk * nN) return false;
        const int blk = L / nN, j = L - blk * nN; u.pm = blk; u.pn = wbase + tab[1 + blk] * nN + j; u.pj = j; return true;
    }
};

__device__ __forceinline__ unsigned cvt_pk_bf16(float lo, float hi) { const bf16x2_t r = __builtin_convertvector((f32x2){lo, hi}, bf16x2_t); return __builtin_bit_cast(unsigned, r); }
__device__ __forceinline__ u32x4 pack8(const float (&v)[8]) { u32x4 w; w.x = cvt_pk_bf16(v[0], v[1]); w.y = cvt_pk_bf16(v[2], v[3]); w.z = cvt_pk_bf16(v[4], v[5]); w.w = cvt_pk_bf16(v[6], v[7]); return w; }

struct EpiProj {
    static constexpr bool GLU = false, ROWCTX = false, COLCTX = true, BASE = false;
    bf16_t *qs, *gs, *vv; f16_t *kf, *kb; const float* lbt;
    __device__ __forceinline__ void colctx(int row, int col, float (&c)[8]) const {
        const int grp = col >> 11, cc = col & 2047;
        if (grp == 2 || grp == 3) { const float* lb = lbt + (grp == 3 ? D : 0) + cc; const f32x4 l0 = *(const f32x4*)lb, l1 = *(const f32x4*)(lb + 4);
            c[0] = 1.f - l0.x; c[1] = 1.f - l0.y; c[2] = 1.f - l0.z; c[3] = 1.f - l0.w; c[4] = 1.f - l1.x; c[5] = 1.f - l1.y; c[6] = 1.f - l1.z; c[7] = 1.f - l1.w; }
        else {
#pragma unroll
            for (int j = 0; j < 8; ++j) c[j] = 0.f; }
    }
    __device__ __forceinline__ void store_cc(int row, int col, const float (&v)[8], const float (&c)[8]) const {
        const int grp = col >> 11, cc = col & 2047; const size_t o = (size_t)row * D + cc;
        if (grp == 0 || grp == 4) { float t[8];
#pragma unroll
            for (int j = 0; j < 8; ++j) t[j] = silu(v[j]);
            *(u32x4*)((grp == 0 ? qs : gs) + o) = pack8(t);
        } else if (grp == 1) { *(u32x4*)(vv + o) = pack8(v); }
        else { f16_t* dst = (grp == 3 ? kb : kf) + o;
            typedef _Float16 h8 __attribute__((ext_vector_type(8))); h8 hv;
#pragma unroll
            for (int j = 0; j < 8; ++j) hv[j] = (_Float16)(c[j] * sigm(-v[j]));
            *(h8*)dst = hv; }
    }
    __device__ __forceinline__ void store(int row, int col, const float (&v)[8]) const { float c[8]; colctx(row, col, c); store_cc(row, col, v, c); }
};
template <bool BASE_BF16>
struct EpiRes {
    static constexpr bool GLU = false, ROWCTX = false, COLCTX = true, BASE = true;
    const void* base; bf16_t* out; const float* gate;
    __device__ __forceinline__ void colctx(int row, int col, float (&c)[8]) const {
        const float* g = gate + (size_t)(row >> 11) * 6 * D + col; const f32x4 g0 = *(const f32x4*)g, g1 = *(const f32x4*)(g + 4);
        c[0] = g0.x; c[1] = g0.y; c[2] = g0.z; c[3] = g0.w; c[4] = g1.x; c[5] = g1.y; c[6] = g1.z; c[7] = g1.w; }
    __device__ __forceinline__ void loadbase(int row, int col, f32x4 (&b)[2]) const { const size_t o = (size_t)row * D + col;
        if constexpr (BASE_BF16) { const u32x4 w = *(const u32x4*)((const bf16_t*)base + o); b[0] = (f32x4){bflo(w.x), bfhi(w.x), bflo(w.y), bfhi(w.y)}; b[1] = (f32x4){bflo(w.z), bfhi(w.z), bflo(w.w), bfhi(w.w)}; }
        else { b[0] = *(const f32x4*)((const float*)base + o); b[1] = *(const f32x4*)((const float*)base + o + 4); } }
    __device__ __forceinline__ void store_cb(int row, int col, const float (&v)[8], const float (&c)[8], const f32x4 (&b)[2]) const {
        const float t[8] = {b[0].x + c[0] * v[0], b[0].y + c[1] * v[1], b[0].z + c[2] * v[2], b[0].w + c[3] * v[3], b[1].x + c[4] * v[4], b[1].y + c[5] * v[5], b[1].z + c[6] * v[6], b[1].w + c[7] * v[7]};
        *(u32x4*)(out + (size_t)row * D + col) = pack8(t);
    }
    __device__ __forceinline__ void store(int row, int col, const float (&v)[8]) const { float c[8]; f32x4 b[2]; colctx(row, col, c); loadbase(row, col, b); store_cb(row, col, v, c, b); }
};
struct EpiSwiGLU {
    static constexpr bool GLU = true, ROWCTX = false, COLCTX = false, BASE = false;
    bf16_t* Hb;
    __device__ __forceinline__ void glu(int row, int colh, const float (&g)[8], const float (&u)[8]) const {
        float t[8];
#pragma unroll
        for (int j = 0; j < 8; ++j) t[j] = silu(g[j]) * u[j];
        *(u32x4*)(Hb + (size_t)row * MHID + colh) = pack8(t);
    }
};
struct EpiDown {
    static constexpr bool GLU = false, ROWCTX = true, COLCTX = false, BASE = false;
    bf16_t* zb; const int* slot_dst; const float* slot_w;
    __device__ __forceinline__ void rowctx(int row, int& dst, float& w) const { dst = slot_dst[row]; w = slot_w[row]; }
    __device__ __forceinline__ void store_ctx(int dst, float w, int col, const float (&v)[8]) const {
        if (dst < 0) return;
        float t[8];
#pragma unroll
        for (int j = 0; j < 8; ++j) t[j] = w * v[j];
        *(u32x4*)(zb + (size_t)dst * D + col) = pack8(t);
    }
    __device__ __forceinline__ void store(int row, int col, const float (&v)[8]) const { int dst; float w; rowctx(row, dst, w); store_ctx(dst, w, col, v); }
};
struct EpiConvGLU {
    static constexpr bool GLU = true, ROWCTX = false, COLCTX = false, BASE = false;
    bf16_t* ub;
    __device__ __forceinline__ void glu(int row, int colh, const float (&a)[8], const float (&g)[8]) const {
        float t[8];
#pragma unroll
        for (int j = 0; j < 8; ++j) t[j] = a[j] * sigm(g[j]);
        *(u32x4*)(ub + (size_t)row * D + colh) = pack8(t);
    }
};

template <bool GATHER = false, class Epi, class Sched>
__device__ __forceinline__ void gemm_gold(LAS unsigned char* lds, const bf16_t* A, const bf16_t* Bt, int K, const Sched& S, const Epi& E, const int* rowmap = nullptr) {
    constexpr int LDG = 260;
    LAS float* As = (LAS float*)lds; LAS float* Bs = As + 16 * LDG;
    const int tid = threadIdx.x, ty = tid >> 4, tx = tid & 15, lr = tid >> 1, lk = (tid & 1) * 8;
    Unit u;
    for (int it = 0; S.next(it, u); ++it) {
        float acc0[8][8], acc1[8][8];
#pragma unroll
        for (int i = 0; i < 8; ++i)
#pragma unroll
            for (int j = 0; j < 8; ++j) { acc0[i][j] = 0.f; acc1[i][j] = 0.f; }
        size_t arow = (size_t)u.pm * 256 + lr; if constexpr (GATHER) { const int d_ = rowmap[arow]; arow = d_ < 0 ? 0 : (size_t)(d_ >> 1); }
        const bf16_t* ap = A + arow * K + lk;
        const bf16_t* bp = Bt + ((size_t)u.pn * 256 + lr) * K + lk;
        for (int k0 = 0; k0 < K; k0 += 16) {
            const u32x4 av = *(const u32x4*)(ap + k0), bv = *(const u32x4*)(bp + k0);
            __syncthreads();
            As[(lk + 0) * LDG + lr] = bflo(av.x); As[(lk + 1) * LDG + lr] = bfhi(av.x); As[(lk + 2) * LDG + lr] = bflo(av.y); As[(lk + 3) * LDG + lr] = bfhi(av.y);
            As[(lk + 4) * LDG + lr] = bflo(av.z); As[(lk + 5) * LDG + lr] = bfhi(av.z); As[(lk + 6) * LDG + lr] = bflo(av.w); As[(lk + 7) * LDG + lr] = bfhi(av.w);
            Bs[(lk + 0) * LDG + lr] = bflo(bv.x); Bs[(lk + 1) * LDG + lr] = bfhi(bv.x); Bs[(lk + 2) * LDG + lr] = bflo(bv.y); Bs[(lk + 3) * LDG + lr] = bfhi(bv.y);
            Bs[(lk + 4) * LDG + lr] = bflo(bv.z); Bs[(lk + 5) * LDG + lr] = bfhi(bv.z); Bs[(lk + 6) * LDG + lr] = bflo(bv.w); Bs[(lk + 7) * LDG + lr] = bfhi(bv.w);
            __syncthreads();
#pragma unroll 4
            for (int k = 0; k < 16; ++k) {
                float a[8];
#pragma unroll
                for (int i = 0; i < 8; ++i) a[i] = As[k * LDG + ty + 32 * i];
                const f32x4 b00 = *(const LAS f32x4*)(Bs + k * LDG + 8 * tx), b01 = *(const LAS f32x4*)(Bs + k * LDG + 8 * tx + 4);
                const f32x4 b10 = *(const LAS f32x4*)(Bs + k * LDG + 128 + 8 * tx), b11 = *(const LAS f32x4*)(Bs + k * LDG + 128 + 8 * tx + 4);
                const float b0[8] = {b00.x, b00.y, b00.z, b00.w, b01.x, b01.y, b01.z, b01.w}, b1[8] = {b10.x, b10.y, b10.z, b10.w, b11.x, b11.y, b11.z, b11.w};
#pragma unroll
                for (int i = 0; i < 8; ++i)
#pragma unroll
                    for (int j = 0; j < 8; ++j) { acc0[i][j] += a[i] * b0[j]; acc1[i][j] += a[i] * b1[j]; }
            }
        }
#pragma unroll
        for (int i = 0; i < 8; ++i) { const int row = u.pm * 256 + ty + 32 * i;
            if constexpr (Epi::GLU) E.glu(row, u.pj * 128 + 8 * tx, acc0[i], acc1[i]);
            else { E.store(row, u.pj * 256 + 8 * tx, acc0[i]); E.store(row, u.pj * 256 + 128 + 8 * tx, acc1[i]); } }
    }
    __syncthreads();
}

template <class Epi>
__device__ __forceinline__ void run_epi(const Epi& E, const f32x4 (&acc)[2][2][4][2], const Unit& u, int wr, int wc, int fr, int fq) {
    const int row0 = u.pm * BM + wr * 64 + fr;
    if constexpr (Epi::ROWCTX) {
        int dst[8]; float wv[8];
#pragma unroll
        for (int q = 0; q < 8; ++q) E.rowctx(row0 + (q >> 2) * HALF + (q & 3) * 16, dst[q], wv[q]);
#pragma unroll
        for (int ai = 0; ai < 2; ++ai)
#pragma unroll
            for (int m = 0; m < 4; ++m)
#pragma unroll
                for (int bj = 0; bj < 2; ++bj) { const f32x4 v0 = acc[ai][bj][m][0], v1 = acc[ai][bj][m][1];
                    const float v[8] = {v0.x, v0.y, v0.z, v0.w, v1.x, v1.y, v1.z, v1.w};
                    E.store_ctx(dst[ai * 4 + m], wv[ai * 4 + m], u.pj * 256 + bj * HALF + wc * 32 + 8 * fq, v); }
        return;
    }
    if constexpr (Epi::COLCTX) {
        float cc[2][8];
#pragma unroll
        for (int bj = 0; bj < 2; ++bj) E.colctx(row0, u.pj * 256 + bj * HALF + wc * 32 + 8 * fq, cc[bj]);
#pragma unroll
        for (int ai = 0; ai < 2; ++ai) {
            f32x4 bs[4][2][2];
            if constexpr (Epi::BASE) {
#pragma unroll
                for (int m = 0; m < 4; ++m)
#pragma unroll
                    for (int bj = 0; bj < 2; ++bj) E.loadbase(row0 + ai * HALF + m * 16, u.pj * 256 + bj * HALF + wc * 32 + 8 * fq, bs[m][bj]);
            }
#pragma unroll
            for (int m = 0; m < 4; ++m)
#pragma unroll
                for (int bj = 0; bj < 2; ++bj) { const f32x4 v0 = acc[ai][bj][m][0], v1 = acc[ai][bj][m][1];
                    const float v[8] = {v0.x, v0.y, v0.z, v0.w, v1.x, v1.y, v1.z, v1.w}; const int row = row0 + ai * HALF + m * 16, col = u.pj * 256 + bj * HALF + wc * 32 + 8 * fq;
                    if constexpr (Epi::BASE) E.store_cb(row, col, v, cc[bj], bs[m][bj]); else E.store_cc(row, col, v, cc[bj]); }
        }
        return;
    }
#pragma unroll
    for (int ai = 0; ai < 2; ++ai)
#pragma unroll
        for (int m = 0; m < 4; ++m) { const int row = row0 + ai * HALF + m * 16;
            if constexpr (Epi::GLU) {
                const f32x4 g0 = acc[ai][0][m][0], g1 = acc[ai][0][m][1], u0 = acc[ai][1][m][0], u1 = acc[ai][1][m][1];
                const float g[8] = {g0.x, g0.y, g0.z, g0.w, g1.x, g1.y, g1.z, g1.w}, uu[8] = {u0.x, u0.y, u0.z, u0.w, u1.x, u1.y, u1.z, u1.w};
                E.glu(row, u.pj * 128 + wc * 32 + 8 * fq, g, uu);
            } else {
#pragma unroll
                for (int bj = 0; bj < 2; ++bj) { const f32x4 v0 = acc[ai][bj][m][0], v1 = acc[ai][bj][m][1];
                    const float v[8] = {v0.x, v0.y, v0.z, v0.w, v1.x, v1.y, v1.z, v1.w};
                    E.store(row, u.pj * 256 + bj * HALF + wc * 32 + 8 * fq, v); }
            } }
}
template <class Epi, class Sched, bool ALIGN_EPI = true, bool GATHER = false>
__device__ __forceinline__ void gemm_fast(LAS unsigned char* lds, const bf16_t* Ag, const bf16_t* Btg, int K, const Sched& S, const Epi& E, const int* rowmap = nullptr) {
    const int tid = threadIdx.x, wid = __builtin_amdgcn_readfirstlane(tid >> 6), lane = tid & 63, wr = wid >> 2, wc = wid & 3, fr = lane & 15, fq = lane >> 4;
    const int nt = K / BK;
    unsigned voffB[2], vC[2][2], vN[2][2]; int RA[2], CA2[2];
#pragma unroll
    for (int i = 0; i < 2; ++i) { int R, C; stage_rc(tid * 16 + i * 8192, R, C); const int Rb = (R & ~31) + perm32(R & 31); RA[i] = R; CA2[i] = C * 2;
        voffB[i] = (unsigned)(Rb * K + C) * 2u;
#pragma unroll
        for (int h = 0; h < 2; ++h) { vC[h][i] = (unsigned)((h * HALF + R) * K + C) * 2u; vN[h][i] = vC[h][i]; } }
#define PG8_GATHER(v, u_) do { _Pragma("unroll") for (int h = 0; h < 2; ++h) _Pragma("unroll") for (int i = 0; i < 2; ++i) { const int d_ = rowmap[(u_).pm * BM + h * HALF + RA[i]]; \
        (v)[h][i] = (unsigned)((d_ < 0 ? 0 : (d_ >> 1)) * K) * 2u + (unsigned)CA2[i]; } } while (0)
    const size_t kstep = (size_t)(BK * 2);
    const size_t hstep = (size_t)HALF * K * 2;
    const size_t tstep = 2 * hstep;
    const unsigned ldsw = (unsigned)wid * 1024u;
    const int aoff = lds_byte(wr * 64 + fr, fq * 8), boff = lds_byte(wc * 32 + fr, fq * 8);
#define PG8_SA(b, h) (((b) * 2 + (h)) * HTB)
#define PG8_SB(b, h) ((4 + (b) * 2 + (h)) * HTB)
#define PG8_STAGE(bufoff, gbase, voff) do { _Pragma("unroll") for (int _i = 0; _i < 2; ++_i) \
        __builtin_amdgcn_global_load_lds((const unsigned*)((const char*)(gbase) + (voff)[_i]), (LAS unsigned*)(lds + (bufoff) + ldsw + _i * 8192), 16, 0, 0); } while (0)
#define PG8_LDA(dst, b, h) do { _Pragma("unroll") for (int m = 0; m < 4; ++m) _Pragma("unroll") for (int k = 0; k < 2; ++k) dst[m][k] = *(const LAS bf16x8*)(lds + PG8_SA(b, h) + aoff + m * 2048 + k * 1024); } while (0)
#define PG8_LDB(dst, b, h) do { _Pragma("unroll") for (int n = 0; n < 2; ++n) _Pragma("unroll") for (int k = 0; k < 2; ++k) dst[n][k] = *(const LAS bf16x8*)(lds + PG8_SB(b, h) + boff + n * 2048 + k * 1024); } while (0)
#define PG8_MMA(ai, bj, At, Bt) do { __builtin_amdgcn_s_setprio(1); _Pragma("unroll") for (int m = 0; m < 4; ++m) _Pragma("unroll") for (int n = 0; n < 2; ++n) _Pragma("unroll") for (int k = 0; k < 2; ++k) \
        acc[ai][bj][m][n] = __builtin_amdgcn_mfma_f32_16x16x32_bf16(Bt[n][k], At[m][k], acc[ai][bj][m][n], 0, 0, 0); __builtin_amdgcn_s_setprio(0); } while (0)
#define PG8_WAIT_V(n) asm volatile("s_waitcnt vmcnt(" #n ")" ::: "memory")
#define PG8_WAIT_L(n) asm volatile("s_waitcnt lgkmcnt(" #n ")" ::: "memory")
#define PG8_BAR __builtin_amdgcn_s_barrier()
#define PG8_SCHED __builtin_amdgcn_sched_barrier(0)
    Unit cur, nxt; int ui = 0;
    if (!S.next(0, cur)) return;
    f32x4 acc[2][2][4][2];
#pragma unroll
    for (int a = 0; a < 2; ++a)
#pragma unroll
        for (int b = 0; b < 2; ++b)
#pragma unroll
            for (int m = 0; m < 4; ++m)
#pragma unroll
                for (int n = 0; n < 2; ++n) acc[a][b][m][n] = (f32x4){0.f, 0.f, 0.f, 0.f};
    bf16x8 At[4][2], B0[2][2], B1[2][2];
    const char* cA = GATHER ? (const char*)Ag : (const char*)Ag + (size_t)cur.pm * tstep; const char* cB = (const char*)Btg + (size_t)cur.pn * tstep;
    if constexpr (GATHER) PG8_GATHER(vC, cur);
    PG8_STAGE(PG8_SB(0, 0), cB, voffB); PG8_STAGE(PG8_SB(0, 1), cB + hstep, voffB); PG8_STAGE(PG8_SA(0, 0), cA, vC[0]); PG8_STAGE(PG8_SA(0, 1), cA, vC[1]);
    if (wr == 1) PG8_BAR;
    PG8_WAIT_V(2); PG8_BAR;
    PG8_STAGE(PG8_SB(1, 0), cB + kstep, voffB); PG8_STAGE(PG8_SA(1, 0), cA + kstep, vC[0]); PG8_STAGE(PG8_SB(1, 1), cB + hstep + kstep, voffB);
    PG8_WAIT_V(6); PG8_BAR;
    for (;;) {
        const bool has_next = S.next(ui + 1, nxt);
        const char* nA = (has_next && !GATHER) ? (const char*)Ag + (size_t)nxt.pm * tstep : cA; const char* nB = has_next ? (const char*)Btg + (size_t)nxt.pn * tstep : cB;
        if constexpr (GATHER) { if (has_next) PG8_GATHER(vN, nxt); else { _Pragma("unroll") for (int h = 0; h < 2; ++h) _Pragma("unroll") for (int i = 0; i < 2; ++i) vN[h][i] = vC[h][i]; } }
        for (int t = 0; t < nt; t += 2) {
            const bool last = (t == nt - 2);
            const char* a1 = cA + (size_t)(t + 1) * kstep;
            const char* a2 = last ? nA : cA + (size_t)(t + 2) * kstep; const char* b2 = last ? nB : cB + (size_t)(t + 2) * kstep;
            const char* a3 = a2 + kstep; const char* b3 = b2 + kstep;
            unsigned vS[2][2];
#pragma unroll
            for (int h = 0; h < 2; ++h)
#pragma unroll
                for (int i = 0; i < 2; ++i) vS[h][i] = (GATHER && last) ? vN[h][i] : vC[h][i];
            PG8_LDB(B0, 0, 0); PG8_LDB(B1, 0, 1); PG8_SCHED; PG8_LDA(At, 0, 0); PG8_STAGE(PG8_SA(1, 1), a1, vC[1]);
            PG8_WAIT_V(8); PG8_WAIT_L(0); PG8_BAR; PG8_MMA(0, 0, At, B0); PG8_MMA(0, 1, At, B1); PG8_BAR; PG8_SCHED;
            PG8_LDA(At, 0, 1); PG8_STAGE(PG8_SB(0, 0), b2, voffB); PG8_STAGE(PG8_SB(0, 1), b2 + hstep, voffB); PG8_STAGE(PG8_SA(0, 0), a2, vS[0]);
            PG8_WAIT_V(8); PG8_WAIT_L(0); PG8_BAR; PG8_MMA(1, 0, At, B0); PG8_MMA(1, 1, At, B1); PG8_BAR; PG8_SCHED;
            PG8_LDB(B0, 1, 0); PG8_LDB(B1, 1, 1); PG8_SCHED; PG8_LDA(At, 1, 0); PG8_STAGE(PG8_SA(0, 1), a2, vS[1]);
            PG8_WAIT_V(8); PG8_WAIT_L(0); PG8_BAR; PG8_MMA(0, 0, At, B0); PG8_MMA(0, 1, At, B1); PG8_BAR; PG8_SCHED;
            PG8_LDA(At, 1, 1); PG8_STAGE(PG8_SB(1, 0), b3, voffB); PG8_STAGE(PG8_SB(1, 1), b3 + hstep, voffB); PG8_STAGE(PG8_SA(1, 0), a3, vS[0]);
            PG8_WAIT_V(8); PG8_WAIT_L(0); PG8_BAR; PG8_MMA(1, 0, At, B0); PG8_MMA(1, 1, At, B1); PG8_BAR; PG8_SCHED;
        }
        if constexpr (ALIGN_EPI) { if (wr == 0) PG8_BAR; }
        run_epi(E, acc, cur, wr, wc, fr, fq);
        if (!has_next) break;
#pragma unroll
        for (int a = 0; a < 2; ++a)
#pragma unroll
            for (int b = 0; b < 2; ++b)
#pragma unroll
                for (int m = 0; m < 4; ++m)
#pragma unroll
                    for (int n = 0; n < 2; ++n) acc[a][b][m][n] = (f32x4){0.f, 0.f, 0.f, 0.f};
        cur = nxt; cA = nA; cB = nB; ++ui;
        if constexpr (GATHER) { _Pragma("unroll") for (int h = 0; h < 2; ++h) _Pragma("unroll") for (int i = 0; i < 2; ++i) vC[h][i] = vN[h][i]; }
        if constexpr (ALIGN_EPI) { if (wr == 1) PG8_BAR; }
    }
    PG8_WAIT_V(0);
    if constexpr (!ALIGN_EPI) { if (wr == 0) PG8_BAR; }
    PG8_BAR;
#undef PG8_GATHER
#undef PG8_SA
#undef PG8_SB
#undef PG8_STAGE
#undef PG8_LDA
#undef PG8_LDB
#undef PG8_MMA
#undef PG8_WAIT_V
#undef PG8_WAIT_L
#undef PG8_BAR
#undef PG8_SCHED
}
template <bool ALIGN_EPI = true, bool GATHER = false, class Epi, class Sched>
__device__ __forceinline__ void gemm_run(LAS unsigned char* lds, const bf16_t* A, const bf16_t* Bt, int K, const Sched& S, const Epi& E, const int* rowmap = nullptr) {
#if GOLD_GEMM
    gemm_gold<GATHER>(lds, A, Bt, K, S, E, rowmap);
#else
    gemm_fast<Epi, Sched, ALIGN_EPI, GATHER>(lds, A, Bt, K, S, E, rowmap);
#endif
}

__device__ __forceinline__ void cvt_tile(LAS float* tl, const float* s0, const float* s1, int ld, bf16_t* dst, int K, int tid) {
    constexpr int LDW = 257;
    const int c4 = tid & 63, r0 = tid >> 6;
    const float* sp = (c4 < 32 ? s0 : s1) + 4 * (c4 & 31);
    f32x4 v[8];
#pragma unroll
    for (int p = 0; p < 8; ++p) v[p] = *(const f32x4*)(sp + (size_t)(p * 8 + r0) * ld);
#pragma unroll
    for (int p = 0; p < 8; ++p) { LAS float* q = tl + (p * 8 + r0) * LDW + 4 * c4; q[0] = v[p].x; q[1] = v[p].y; q[2] = v[p].z; q[3] = v[p].w; }
    __syncthreads();
    const int ch = tid & 7, n0 = tid >> 3;
#pragma unroll
    for (int p = 0; p < 4; ++p) { const int n = p * 64 + n0; const LAS float* s = tl + (8 * ch) * LDW + n;
        u32x4 o; o.x = pk2(s[0], s[LDW]); o.y = pk2(s[2 * LDW], s[3 * LDW]); o.z = pk2(s[4 * LDW], s[5 * LDW]); o.w = pk2(s[6 * LDW], s[7 * LDW]);
        __builtin_nontemporal_store(o, (u32x4*)(dst + (size_t)n * K + 8 * ch)); }
    __syncthreads();
}
__device__ __forceinline__ void ph_pre(const Ctx& C) {
    for (int i = C.bid * NTHREADS + C.tid; i < 2 * D; i += C.nb * NTHREADS) {
        const int d = i / D, cc = i % D;
        const float a0 = C.hlb[(d * 3 + 0) * D + cc], a1 = C.hlb[(d * 3 + 1) * D + cc], a2 = C.hlb[(d * 3 + 2) * D + cc];
        const float m = fmaxf(a0, fmaxf(a1, a2)); const float e0 = __expf(a0 - m), e1 = __expf(a1 - m), e2 = __expf(a2 - m);
        C.lbt[i] = e0 / (e0 + e1 + e2);
    }
    LAS float* sl = (LAS float*)C.lds;
    constexpr int N_ADA = 384, N_CVT = 1280 + 256 + 512 + 256;
    for (int t = C.bid; t < N_ADA; t += C.nb) {
        int tid = C.tid; asm volatile("" : "+v"(tid));
        {
            const int l = t / 192, rem = t % 192, ks = rem / 6, cb = rem % 6;
            for (int i = tid; i < 9 * 64; i += NTHREADS) { const int r = i >> 6, kk = i & 63; const float v = r < 8 ? C.c[r * D + ks * 64 + kk] : C.c_ctx[ks * 64 + kk]; sl[i] = silu(v); }
            __syncthreads();
            const int n = (cb * 512 + tid) * 4;
            f32x4 acc[9];
#pragma unroll
            for (int r = 0; r < 9; ++r) acc[r] = (f32x4){0.f, 0.f, 0.f, 0.f};
            const float* wp = C.ada_w + ((size_t)l * D + ks * 64) * (6 * D) + n;
#pragma unroll 16
            for (int kk = 0; kk < 64; ++kk) { const f32x4 w = *(const f32x4*)(wp + (size_t)kk * 6 * D);
#pragma unroll
                for (int r = 0; r < 9; ++r) acc[r] += sl[r * 64 + kk] * w; }
#pragma unroll
            for (int r = 0; r < 9; ++r) *(f32x4*)(C.modp + ((size_t)(l * 32 + ks) * 9 + r) * (6 * D) + n) = acc[r];
            __syncthreads();
        }
    }
}
__device__ __forceinline__ void cvt_moe_task(const Ctx& C, int r, const float*& src, int& ld, bf16_t*& dst, int& K, int tid) {
    const int c4 = tid & 63, r0 = tid >> 6; const int ly = r / 12288, jj = r - ly * 12288;
    const bool gu = jj < 8192; const int r2 = gu ? ly * 8192 + jj : ly * 4096 + (jj - 8192);
    const int le = gu ? (r2 >> 7) : (r2 >> 6), q = gu ? (r2 & 127) : (r2 & 63), nt = gu ? (q >> 5) : (q >> 3), kt = gu ? (q & 31) : (q & 7);
    const float* sg = (c4 < 32 ? C.wg : C.wu) + (size_t)le * D * MHID + (size_t)(64 * kt + r0) * MHID + 128 * nt + 4 * (c4 & 31);
    const float* sd = C.wd + (size_t)le * MHID * D + (size_t)(64 * kt + r0) * D + 256 * nt + (c4 < 32 ? 0 : 128) + 4 * (c4 & 31);
    src = gu ? sg : sd; ld = gu ? MHID : D; K = gu ? D : MHID;
    dst = gu ? C.Wgu + ((size_t)le * 1024 + 256 * nt) * D + 64 * kt : C.Wd + ((size_t)le * D + 256 * nt) * MHID + 64 * kt;
}
__device__ __forceinline__ void cvt_issue(const Ctx& C, int r, f32x4 (&v)[8], int tid) {
    const float* src; int ld, K; bf16_t* dst; cvt_moe_task(C, r, src, ld, dst, K, tid);
#pragma unroll
    for (int p = 0; p < 8; ++p) v[p] = __builtin_nontemporal_load((const f32x4*)(src + (size_t)(p * 8) * ld));
}
__device__ __forceinline__ void cvt_to_lds(LAS float* tl, const f32x4 (&v)[8], int tid) {
    const int c4 = tid & 63, r0 = tid >> 6;
#pragma unroll
    for (int p = 0; p < 8; ++p) *(LAS f32x4*)((LAS char*)tl + (p * 8 + r0) * 1024 + ((c4 ^ p) << 4)) = v[p];
}
__device__ __forceinline__ void cvt_store_to(const LAS float* tl, bf16_t* dst, int K, int tid);
__device__ __forceinline__ void cvt_store(const Ctx& C, int r, const LAS float* tl, int tid) {
    const float* src; int ld, K; bf16_t* dst; cvt_moe_task(C, r, src, ld, dst, K, tid);
    cvt_store_to(tl, dst, K, tid);
}
__device__ __forceinline__ void cvt_store_to(const LAS float* tl, bf16_t* dst, int K, int tid) {
    const int ch = tid & 7, n0 = tid >> 3;
#pragma unroll
    for (int p = 0; p < 4; ++p) { const int n = p * 64 + n0; const LAS float* sp = (const LAS float*)((const LAS char*)tl + (8 * ch) * 1024 + (((n >> 2) ^ ch) << 4) + (n & 3) * 4);
        u32x4 o; o.x = pk2(sp[0], sp[256]); o.y = pk2(sp[2 * 256], sp[3 * 256]); o.z = pk2(sp[4 * 256], sp[5 * 256]); o.w = pk2(sp[6 * 256], sp[7 * 256]);
        __builtin_nontemporal_store(o, (u32x4*)(dst + (size_t)n * K + 8 * ch)); }
}
template <int COUNT>
__device__ __forceinline__ void ph_cvt_moe_fixed(const Ctx& C, int first, int stride) {
    LAS float* tl = (LAS float*)C.lds;
    int tid = C.tid; asm volatile("" : "+v"(tid));
    f32x4 v0[8], v1[8], v2[8], v3[8];
    cvt_issue(C, first, v0, tid); cvt_issue(C, first + stride, v1, tid); cvt_issue(C, first + 2 * stride, v2, tid); cvt_issue(C, first + 3 * stride, v3, tid);
#define CVT_STEP(v, jj) { LAS float* tb = tl + ((jj) & 1) * 16384; cvt_to_lds(tb, v, tid); __syncthreads(); { const int jn = (jj) + 4 < COUNT ? (jj) + 4 : COUNT - 1; cvt_issue(C, first + jn * stride, v, tid); } \
        cvt_store(C, first + (jj) * stride, tb, tid); }
#pragma unroll
    for (int j = 0; j < COUNT; j += 4) { CVT_STEP(v0, j) CVT_STEP(v1, j + 1) CVT_STEP(v2, j + 2) CVT_STEP(v3, j + 3) }
#undef CVT_STEP
    __syncthreads();
}
__device__ __forceinline__ void ph_cvt_moe(const Ctx& C, int first, int count, int stride) {
    if (count == 48) { ph_cvt_moe_fixed<48>(C, first, stride); return; }
    LAS float* tl = (LAS float*)C.lds;
    if (count < 4) return;
    int tid = C.tid; asm volatile("" : "+v"(tid));
    f32x4 v0[8], v1[8], v2[8], v3[8];
    cvt_issue(C, first, v0, tid); cvt_issue(C, first + stride, v1, tid); cvt_issue(C, first + 2 * stride, v2, tid); cvt_issue(C, first + 3 * stride, v3, tid);
#define CVT_STEP(v, jj, par) { LAS float* tb = tl + (par) * 16384; cvt_to_lds(tb, v, tid); __syncthreads(); { const int jn = (jj) + 4 < count ? (jj) + 4 : count - 1; cvt_issue(C, first + jn * stride, v, tid); } \
        cvt_store(C, first + (jj) * stride, tb, tid); }
    for (int j = 0; j < count; j += 4) { CVT_STEP(v0, j, 0) CVT_STEP(v1, j + 1, 1) CVT_STEP(v2, j + 2, 0) CVT_STEP(v3, j + 3, 1) }
#undef CVT_STEP
    __syncthreads();
}
__device__ __forceinline__ void dense_task(const Ctx& C, int r, const float*& s0, const float*& s1, int& ld, bf16_t*& dst) {
    const int kt = r & 31;
    if (r < 1280) { const int nt = r >> 5; s0 = C.w_in + (size_t)(64 * kt) * 10240 + 256 * nt; s1 = s0 + 128; ld = 10240; dst = C.Win + (size_t)(256 * nt) * D + 64 * kt; return; } r -= 1280;
    if (r < 256) { const int nt = r >> 5; s0 = C.w_out + (size_t)(64 * kt) * D + 256 * nt; s1 = s0 + 128; ld = D; dst = C.Wout + (size_t)(256 * nt) * D + 64 * kt; return; } r -= 256;
    if (r < 512) { const int nt = r >> 5; s0 = C.pw1 + (size_t)(64 * kt) * 4096 + 128 * nt; s1 = s0 + 2048; ld = 4096; dst = C.Wpw1 + (size_t)(256 * nt) * D + 64 * kt; return; } r -= 512;
    { const int nt = r >> 5; s0 = C.pw2 + (size_t)(64 * kt) * D + 256 * nt; s1 = s0 + 128; ld = D; dst = C.Wpw2 + (size_t)(256 * nt) * D + 64 * kt; }
}
__device__ __forceinline__ void ph_pre_cvt(const Ctx& C) {
    constexpr int N_CVT = 1280 + 256 + 512 + 256;
    LAS float* tl = (LAS float*)C.lds;
    int tid = C.tid; asm volatile("" : "+v"(tid));
    const int c4 = tid & 63, r0 = tid >> 6;
    int r = C.bid; if (r >= N_CVT) return;
    const float *s0, *s1; int ld; bf16_t* dst; dense_task(C, r, s0, s1, ld, dst);
    f32x4 vc[8], vn[8];
    { const float* sp = (c4 < 32 ? s0 : s1) + 4 * (c4 & 31) + (size_t)r0 * ld;
#pragma unroll
      for (int p = 0; p < 8; ++p) vc[p] = __builtin_nontemporal_load((const f32x4*)(sp + (size_t)(p * 8) * ld)); }
    int par = 0;
    for (; r < N_CVT; r += C.nb) {
        const int rn = r + C.nb < N_CVT ? r + C.nb : r;
        const float *n0, *n1; int nld; bf16_t* ndst; dense_task(C, rn, n0, n1, nld, ndst);
        { const float* sp = (c4 < 32 ? n0 : n1) + 4 * (c4 & 31) + (size_t)r0 * nld;
#pragma unroll
          for (int p = 0; p < 8; ++p) vn[p] = __builtin_nontemporal_load((const f32x4*)(sp + (size_t)(p * 8) * nld)); }
        LAS float* tb = tl + par * 16384; par ^= 1;
        cvt_to_lds(tb, vc, tid); __syncthreads();
        cvt_store_to(tb, dst, D, tid);
#pragma unroll
        for (int p = 0; p < 8; ++p) vc[p] = vn[p];
        dst = ndst;
    }
    __syncthreads();
}
__device__ __forceinline__ void ph_modr(const Ctx& C) {
    constexpr int N4 = 6 * D / 4;
    for (int i = C.bid * NTHREADS + C.tid; i < 2 * 9 * N4; i += C.nb * NTHREADS) {
        const int l = i / (9 * N4), rem = i % (9 * N4), r = rem / N4, n4 = rem % N4;
        f32x4 s = *(const f32x4*)(C.ada_b + (size_t)l * 6 * D + 4 * n4);
#pragma unroll
        for (int ks = 0; ks < 32; ++ks) s += *(const f32x4*)(C.modp + ((size_t)(l * 32 + ks) * 9 + r) * (6 * D) + 4 * n4);
        *(f32x4*)(C.mod + (size_t)(l * 9 + r) * 6 * D + 4 * n4) = s;
    }
}
__device__ __forceinline__ float row_rstd(const f32x4 (&v)[8]) {
    float ss = 0.f;
#pragma unroll
    for (int j = 0; j < 8; ++j) ss += (v[j].x * v[j].x + v[j].y * v[j].y) + (v[j].z * v[j].z + v[j].w * v[j].w);
    return rsqrtf(wave_sum(ss) * (1.f / D) + EPS);
}
__device__ __forceinline__ void norm_mod(const f32x4 (&v)[8], f32x4 (&y)[8], const float* g, const float* shift, const float* scale, int lane) {
    const float rstd = row_rstd(v);
#pragma unroll
    for (int j = 0; j < 8; ++j) { const int col = j * 256 + lane * 4;
        const f32x4 gg = *(const f32x4*)(g + col), sh = *(const f32x4*)(shift + col), sc = *(const f32x4*)(scale + col);
        y[j] = (v[j] * rstd) * gg * (sc + 1.f) + sh; }
}
__device__ __forceinline__ f32x4 ld_bf16x4(const bf16_t* p) { const u32x2 w = *(const u32x2*)p; return (f32x4){bflo(w.x), bfhi(w.x), bflo(w.y), bfhi(w.y)}; }
__device__ __forceinline__ void store_row_bf16(const f32x4 (&y)[8], bf16_t* dst, int lane) {
#pragma unroll
    for (int j = 0; j < 8; ++j) *(u32x2*)(dst + j * 256 + lane * 4) = (u32x2){pk2(y[j].x, y[j].y), pk2(y[j].z, y[j].w)};
}
__device__ __forceinline__ const float* n1_src(const Ctx& C, int row) { return row < NT ? C.x + (size_t)row * D : C.ctxx + (size_t)(row - NT) * D; }
__device__ __forceinline__ void ph_n1_l0(const Ctx& C) {
    const int nw = C.nb * 8, per = (NR + nw - 1) / nw;
    int row = (C.bid * 8 + C.wave) * per; const int rend = row + per < NR ? row + per : NR;
    if (row >= rend) return;
    f32x4 vn[8], gsc[8], shf[8]; int rb = -1;
    { const float* src = n1_src(C, row);
#pragma unroll
      for (int j = 0; j < 8; ++j) vn[j] = *(const f32x4*)(src + j * 256 + C.lane * 4); }
    for (; row < rend; ++row) {
        f32x4 v[8], y[8];
#pragma unroll
        for (int j = 0; j < 8; ++j) v[j] = vn[j];
        { const int nr = row + 1 < rend ? row + 1 : row; const float* src = n1_src(C, nr);
#pragma unroll
          for (int j = 0; j < 8; ++j) vn[j] = *(const f32x4*)(src + j * 256 + C.lane * 4); }
        const int r = row < NT ? (row >> 11) : 8;
        if (r != rb) { rb = r; const float* shift = modptr(C, 0, r, 0); const float* scale = modptr(C, 0, r, 1);
#pragma unroll
            for (int j = 0; j < 8; ++j) { const int col = j * 256 + C.lane * 4; gsc[j] = *(const f32x4*)(C.n1g + col) * (*(const f32x4*)(scale + col) + 1.f); shf[j] = *(const f32x4*)(shift + col); } }
        const float rstd = row_rstd(v);
#pragma unroll
        for (int j = 0; j < 8; ++j) y[j] = (v[j] * rstd) * gsc[j] + shf[j];
        store_row_bf16(y, C.A + (size_t)row * D, C.lane);
    }
}
__device__ __forceinline__ void ph_scan_gold(const Ctx& C) {
    LAS float* qL = (LAS float*)C.lds; LAS float* kL = qL + 16 * 128; LAS float* vL = kL + 16 * 128; LAS float* part = vL + 16 * 128;
    const int vcol = C.tid & 127, kq = C.tid >> 7;
    for (int unit = C.bid; unit < NBATCH * NHEAD * 2; unit += C.nb) {
        const int dir = unit & 1, bh = unit >> 1, b = bh >> 4, h = bh & 15;
        const f16_t* kx = dir ? C.kb : C.kf; bf16_t* ob = dir ? C.obw : C.ofw;
        float S[32];
#pragma unroll
        for (int j = 0; j < 32; ++j) S[j] = 0.f;
        for (int g = 0; g < (CTXL + SEQ) / 16; ++g) {
            const bool lat = g >= CTXL / 16; const int gl = lat ? g - CTXL / 16 : g; const int len = lat ? SEQ : CTXL; const int rbase = lat ? b * SEQ : NT + b * CTXL;
            __syncthreads();
            for (int idx = C.tid; idx < 16 * 128; idx += NTHREADS) { const int tt = idx >> 7, kk = idx & 127; const int t = dir ? (len - 1 - (16 * gl + tt)) : 16 * gl + tt;
                const size_t o = (size_t)(rbase + t) * D + h * 128 + kk;
                kL[idx] = (float)kx[o]; vL[idx] = bf2f(C.vv[o]); if (lat) qL[idx] = bf2f(C.qs[o]); }
            __syncthreads();
            for (int tt = 0; tt < 16; ++tt) { const float vv = vL[tt * 128 + vcol]; float p = 0.f;
#pragma unroll
                for (int j = 0; j < 32; ++j) { const float kv = kL[tt * 128 + 32 * kq + j]; S[j] = (1.f - kv) * S[j] + kv * vv; if (lat) p += S[j] * qL[tt * 128 + 32 * kq + j]; }
                if (lat) part[(tt * 4 + kq) * 128 + vcol] = p; }
            if (lat) { __syncthreads();
                for (int idx = C.tid; idx < 16 * 128; idx += NTHREADS) { const int tt = idx >> 7, vc2 = idx & 127; const int t = dir ? (len - 1 - (16 * gl + tt)) : 16 * gl + tt;
                    const float o = (part[(tt * 4 + 0) * 128 + vc2] + part[(tt * 4 + 1) * 128 + vc2]) + (part[(tt * 4 + 2) * 128 + vc2] + part[(tt * 4 + 3) * 128 + vc2]);
                    ob[(size_t)(rbase + t) * D + h * 128 + vc2] = (bf16_t)f2bf(o); } }
        }
    }
    __syncthreads();
}
__device__ __forceinline__ int scan_row(int b, int dir, int c, int u) {
    const int pos = dir ? 63 - u : u;
    if (c < 4) return NT + b * CTXL + (dir ? 3 - c : c) * 64 + pos;
    return b * SEQ + (dir ? 31 - (c - 4) : (c - 4)) * 64 + pos;
}
__device__ __forceinline__ void ph_scan_fast(const Ctx& C) {
    LAS unsigned char* L = C.lds;
    constexpr int QT = 0, KT = 17408, KET = 34816, VT = 53248, PP = 71680, ST = 80896, TOT = 115712, ER = 119808, EL = 120320;
    const int lane = C.lane, w = C.wave, fr = lane & 15, fq = lane >> 4, cp = lane, sg = w;
    typedef _Float16 h2_t __attribute__((ext_vector_type(2)));
    for (int unit = C.bid; unit < NBATCH * NHEAD * 2; unit += C.nb) {
        const int dir = unit & 1, bh = unit >> 1, b = bh >> 4, h = bh & 15;
        const f16_t* kx = dir ? C.kb : C.kf; bf16_t* ob = dir ? C.obw : C.ofw;
        f32x4 S[8];
#pragma unroll
        for (int i = 0; i < 8; ++i) S[i] = (f32x4){0.f, 0.f, 0.f, 0.f};
        unsigned rq[8], rv[8]; h2_t rk[8];
        const unsigned lane_off = (unsigned)(h * 128 + 2 * cp) * 2u;
#define SCAN_ROWP(buf, c_, i_) ((const char*)(buf) + (size_t)__builtin_amdgcn_readfirstlane(scan_row(b, dir, (c_), 8 * sg + (i_))) * (D * 2) + lane_off)
#pragma unroll
        for (int i = 0; i < 8; ++i) { rk[i] = *(const h2_t*)SCAN_ROWP(kx, 0, i); rv[i] = *(const unsigned*)SCAN_ROWP(C.vv, 0, i); rq[i] = 0u; }
        for (int c = 0; c < 36; ++c) {
            const bool lat = c >= 4;
            float kk0[8], kk1[8], lp0[8], lp1[8];
            { float a0 = 1.f, a1 = 1.f;
#pragma unroll
              for (int i = 0; i < 8; ++i) { kk0[i] = (float)rk[i].x; kk1[i] = (float)rk[i].y; a0 *= 1.f - kk0[i]; a1 *= 1.f - kk1[i]; lp0[i] = a0; lp1[i] = a1; }
              *(LAS f32x2*)(L + TOT + sg * 512 + cp * 8) = (f32x2){a0, a1}; }
            __syncthreads();
            { float pre0 = 1.f, pre1 = 1.f, R0 = 1.f, R1 = 1.f, L0 = 1.f, L1 = 1.f;
#pragma unroll
              for (int g = 0; g < 8; ++g) { const f32x2 t = *(const LAS f32x2*)(L + TOT + g * 512 + cp * 8);
                  if (g < sg) { pre0 *= t.x; pre1 *= t.y; } if (g < 4) { R0 *= t.x; R1 *= t.y; } L0 *= t.x; L1 *= t.y; }
              R0 = fmaxf(R0, 1e-30f); R1 = fmaxf(R1, 1e-30f);
              const float iR0 = __builtin_amdgcn_rcpf(R0), iR1 = __builtin_amdgcn_rcpf(R1);
              float ke0[8], ke1[8];
#pragma unroll
              for (int i = 0; i < 8; ++i) { const float pf0 = fmaxf(pre0 * lp0[i], 1e-30f), pf1 = fmaxf(pre1 * lp1[i], 1e-30f);
                  const float r0 = __builtin_amdgcn_rcpf(pf0), r1 = __builtin_amdgcn_rcpf(pf1);
                  { const int u = 8 * sg + i;
                      *(LAS unsigned*)(L + QT + u * 272 + cp * 4) = cvt_pk_bf16(bflo(rq[i]) * pf0 * iR0, bfhi(rq[i]) * pf1 * iR1);
                      *(LAS unsigned*)(L + KT + u * 272 + cp * 4) = cvt_pk_bf16(kk0[i] * r0 * R0, kk1[i] * r1 * R1); }
                  ke0[i] = kk0[i] * r0 * L0; ke1[i] = kk1[i] * r1 * L1; }
              *(LAS u32x4*)(L + KET + (2 * cp) * 144 + sg * 16) = (u32x4){cvt_pk_bf16(ke0[0], ke0[1]), cvt_pk_bf16(ke0[2], ke0[3]), cvt_pk_bf16(ke0[4], ke0[5]), cvt_pk_bf16(ke0[6], ke0[7])};
              *(LAS u32x4*)(L + KET + (2 * cp + 1) * 144 + sg * 16) = (u32x4){cvt_pk_bf16(ke1[0], ke1[1]), cvt_pk_bf16(ke1[2], ke1[3]), cvt_pk_bf16(ke1[4], ke1[5]), cvt_pk_bf16(ke1[6], ke1[7])};
              *(LAS u32x4*)(L + VT + (2 * cp) * 144 + sg * 16) = (u32x4){(rv[0] & 0xffffu) | (rv[1] << 16), (rv[2] & 0xffffu) | (rv[3] << 16), (rv[4] & 0xffffu) | (rv[5] << 16), (rv[6] & 0xffffu) | (rv[7] << 16)};
              *(LAS u32x4*)(L + VT + (2 * cp + 1) * 144 + sg * 16) = (u32x4){(rv[0] >> 16) | (rv[1] & 0xffff0000u), (rv[2] >> 16) | (rv[3] & 0xffff0000u), (rv[4] >> 16) | (rv[5] & 0xffff0000u), (rv[6] >> 16) | (rv[7] & 0xffff0000u)};
              if (sg == 0) { *(LAS f32x2*)(L + ER + cp * 8) = (f32x2){R0, R1}; *(LAS f32x2*)(L + EL + cp * 8) = (f32x2){L0, L1}; } }
            if (c + 1 < 36) {
#pragma unroll
                for (int i = 0; i < 8; ++i) { rk[i] = *(const h2_t*)SCAN_ROWP(kx, c + 1, i); rv[i] = *(const unsigned*)SCAN_ROWP(C.vv, c + 1, i); if (c + 1 >= 4) rq[i] = *(const unsigned*)SCAN_ROWP(C.qs, c + 1, i); }
            }
            __syncthreads();
            if (lat) {
                { const int tj = w & 3, sp = w >> 2; bf16x8 bq[4], ak[2][4];
#pragma unroll
                  for (int ks = 0; ks < 4; ++ks) bq[ks] = *(const LAS bf16x8*)(L + QT + (16 * tj + fr) * 272 + ks * 64 + fq * 16);
#pragma unroll
                  for (int hh = 0; hh < 2; ++hh)
#pragma unroll
                      for (int ks = 0; ks < 4; ++ks) ak[hh][ks] = *(const LAS bf16x8*)(L + KT + (16 * (2 * sp + hh) + fr) * 272 + ks * 64 + fq * 16);
                  asm volatile("" ::: "memory");
#pragma unroll
                  for (int hh = 0; hh < 2; ++hh) { const int si = 2 * sp + hh; f32x4 acc = (f32x4){0.f, 0.f, 0.f, 0.f};
#pragma unroll
                      for (int ks = 0; ks < 4; ++ks) acc = __builtin_amdgcn_mfma_f32_16x16x32_bf16(ak[hh][ks], bq[ks], acc, 0, 0, 0);
                      { const int s0 = 16 * si + 4 * fq, tt = 16 * tj + fr; acc.x = (s0 + 0 <= tt) ? acc.x : 0.f; acc.y = (s0 + 1 <= tt) ? acc.y : 0.f; acc.z = (s0 + 2 <= tt) ? acc.z : 0.f; acc.w = (s0 + 3 <= tt) ? acc.w : 0.f; }
                      *(LAS u32x2*)(L + PP + (16 * tj + fr) * 144 + (16 * si + 4 * fq) * 2) = (u32x2){cvt_pk_bf16(acc.x, acc.y), cvt_pk_bf16(acc.z, acc.w)}; } }
                { const f32x4 er = *(const LAS f32x4*)(L + ER + (16 * w + 4 * fq) * 4);
#pragma unroll
                  for (int vt = 0; vt < 8; ++vt) { const f32x4 sv = S[vt] * er; *(LAS u32x2*)(L + ST + (16 * vt + fr) * 272 + (16 * w + 4 * fq) * 2) = (u32x2){cvt_pk_bf16(sv.x, sv.y), cvt_pk_bf16(sv.z, sv.w)}; } }
                __syncthreads();
                { bf16x8 av[2], as4[4], fb[2][6];
#pragma unroll
                  for (int ks = 0; ks < 2; ++ks) av[ks] = *(const LAS bf16x8*)(L + VT + (16 * w + fr) * 144 + ks * 64 + fq * 16);
#pragma unroll
                  for (int ks = 0; ks < 4; ++ks) as4[ks] = *(const LAS bf16x8*)(L + ST + (16 * w + fr) * 272 + ks * 64 + fq * 16);
#define SCAN_LDC(buf, tj_) { _Pragma("unroll") for (int ks = 0; ks < 2; ++ks) fb[buf][ks] = *(const LAS bf16x8*)(L + PP + (16 * (tj_) + fr) * 144 + ks * 64 + fq * 16); \
                             _Pragma("unroll") for (int ks = 0; ks < 4; ++ks) fb[buf][2 + ks] = *(const LAS bf16x8*)(L + QT + (16 * (tj_) + fr) * 272 + ks * 64 + fq * 16); }
                  SCAN_LDC(0, 0)
#pragma unroll
                  for (int tj = 0; tj < 4; ++tj) { if (tj + 1 < 4) SCAN_LDC((tj + 1) & 1, tj + 1)
                      asm volatile("" ::: "memory");
                      f32x4 o = (f32x4){0.f, 0.f, 0.f, 0.f};
#pragma unroll
                      for (int ks = 0; ks < 2; ++ks) o = __builtin_amdgcn_mfma_f32_16x16x32_bf16(av[ks], fb[tj & 1][ks], o, 0, 0, 0);
#pragma unroll
                      for (int ks = 0; ks < 4; ++ks) o = __builtin_amdgcn_mfma_f32_16x16x32_bf16(as4[ks], fb[tj & 1][2 + ks], o, 0, 0, 0);
                      *(u32x2*)(ob + (size_t)scan_row(b, dir, c, 16 * tj + fr) * D + h * 128 + 16 * w + 4 * fq) = (u32x2){cvt_pk_bf16(o.x, o.y), cvt_pk_bf16(o.z, o.w)}; }
#undef SCAN_LDC
                }
            }
            { const f32x4 el = *(const LAS f32x4*)(L + EL + (16 * w + 4 * fq) * 4); bf16x8 ak[2], bv[2][8];
#pragma unroll
              for (int ks = 0; ks < 2; ++ks) ak[ks] = *(const LAS bf16x8*)(L + KET + (16 * w + fr) * 144 + ks * 64 + fq * 16);
#define SCAN_LDD(buf, v0_) { _Pragma("unroll") for (int q = 0; q < 4; ++q) _Pragma("unroll") for (int ks = 0; ks < 2; ++ks) bv[buf][2 * q + ks] = *(const LAS bf16x8*)(L + VT + (16 * ((v0_) + q) + fr) * 144 + ks * 64 + fq * 16); }
              SCAN_LDD(0, 0) SCAN_LDD(1, 4)
              asm volatile("" ::: "memory");
#pragma unroll
              for (int vt = 0; vt < 8; ++vt) { S[vt] = S[vt] * el;
#pragma unroll
                  for (int ks = 0; ks < 2; ++ks) S[vt] = __builtin_amdgcn_mfma_f32_16x16x32_bf16(ak[ks], bv[vt >> 2][2 * (vt & 3) + ks], S[vt], 0, 0, 0); }
#undef SCAN_LDD
            }
        }
        __syncthreads();
    }
}
__device__ __forceinline__ void ph_rdprep(const Ctx& C) {
    const int stride = C.nb * 8; int row = C.bid * 8 + C.wave;
    u32x4 an[4], bn[4], gn[4];
#define RD_LOAD(r_) do { const size_t ro_ = (size_t)(r_) * D + C.lane * 8; _Pragma("unroll") for (int j = 0; j < 4; ++j) { \
        an[j] = *(const u32x4*)(C.ofw + ro_ + j * 512); bn[j] = *(const u32x4*)(C.obw + ro_ + j * 512); gn[j] = *(const u32x4*)(C.gs + ro_ + j * 512); } } while (0)
    RD_LOAD(row < NT ? row : NT - 1);
    const f32x4 og0 = *(const f32x4*)(C.onorm + (C.lane & 15) * 8), og1 = *(const f32x4*)(C.onorm + (C.lane & 15) * 8 + 4);
    for (; row < NT; row += stride) {
        u32x4 a[4], b[4], g[4];
#pragma unroll
        for (int j = 0; j < 4; ++j) { a[j] = an[j]; b[j] = bn[j]; g[j] = gn[j]; }
        RD_LOAD(row + stride < NT ? row + stride : NT - 1);
#pragma unroll
        for (int j = 0; j < 4; ++j) {
            const float o0 = bflo(a[j].x) + bflo(b[j].x), o1 = bfhi(a[j].x) + bfhi(b[j].x), o2 = bflo(a[j].y) + bflo(b[j].y), o3 = bfhi(a[j].y) + bfhi(b[j].y);
            const float o4 = bflo(a[j].z) + bflo(b[j].z), o5 = bfhi(a[j].z) + bfhi(b[j].z), o6 = bflo(a[j].w) + bflo(b[j].w), o7 = bfhi(a[j].w) + bfhi(b[j].w);
            float ss = ((o0 * o0 + o1 * o1) + (o2 * o2 + o3 * o3)) + ((o4 * o4 + o5 * o5) + (o6 * o6 + o7 * o7));
#pragma unroll
            for (int o = 1; o < 16; o <<= 1) ss += __shfl_xor(ss, o);
            const float rstd = rsqrtf(ss * (1.f / HK) + EPS);
            u32x4 w;
            w.x = pk2(o0 * rstd * og0.x * bflo(g[j].x), o1 * rstd * og0.y * bfhi(g[j].x)); w.y = pk2(o2 * rstd * og0.z * bflo(g[j].y), o3 * rstd * og0.w * bfhi(g[j].y));
            w.z = pk2(o4 * rstd * og1.x * bflo(g[j].z), o5 * rstd * og1.y * bfhi(g[j].z)); w.w = pk2(o6 * rstd * og1.z * bflo(g[j].w), o7 * rstd * og1.w * bfhi(g[j].w));
            *(u32x4*)(C.A + (size_t)row * D + j * 512 + C.lane * 8) = w; }
    }
#undef RD_LOAD
}
__device__ __forceinline__ void ph_rprep(const Ctx& C) {
    for (int t = C.bid * 8 + C.wave; t < 2 * 8 * 80; t += C.nb * 8) {
        const int l = t / 640, rem = t % 640, b = rem / 80, n = rem % 80;
        const float* g2 = C.n2g + (size_t)l * D; const float* sh = modptr(C, l, b, 3); const float* sc = modptr(C, l, b, 4);
        const float* wsrc; int wstride; float bias0 = 0.f;
        if (n < 8) { wsrc = C.wr1 + (size_t)l * D * 8 + n; wstride = 8; bias0 = C.br1[l * 8 + n]; }
        else if (n < 72) { const int g = (n - 8) >> 3, e = (n - 8) & 7; wsrc = C.wr2 + ((size_t)(l * 8 + g) * D) * 8 + e; wstride = 8; bias0 = C.br2[(l * 8 + g) * 8 + e]; }
        else { wsrc = nullptr; wstride = 0; }
        bf16_t* oh = C.rwh + (size_t)(l * 8 + b) * 80 * D; bf16_t* ol = C.rwl + (size_t)(l * 8 + b) * 80 * D;
        float bs = 0.f;
#pragma unroll
        for (int j = 0; j < 8; ++j) { const int col = j * 256 + C.lane * 4; float wv[4];
#pragma unroll
            for (int e = 0; e < 4; ++e) wv[e] = wsrc ? wsrc[(size_t)(col + e) * wstride] : 0.f;
            const f32x4 gg = *(const f32x4*)(g2 + col), s4 = *(const f32x4*)(sc + col), h4 = *(const f32x4*)(sh + col);
            const float w0 = gg.x * (1.f + s4.x) * wv[0], w1 = gg.y * (1.f + s4.y) * wv[1], w2 = gg.z * (1.f + s4.z) * wv[2], w3 = gg.w * (1.f + s4.w) * wv[3];
            bs += (h4.x * wv[0] + h4.y * wv[1]) + (h4.z * wv[2] + h4.w * wv[3]);
            const unsigned p0 = cvt_pk_bf16(w0, w1), p1 = cvt_pk_bf16(w2, w3);
            const size_t fo = ((size_t)((col >> 5) * 5 + (n >> 4)) * 64 + ((col & 31) >> 3) * 16 + (n & 15)) * 8 + (col & 7);
            *(u32x2*)(oh + fo) = (u32x2){p0, p1};
            *(u32x2*)(ol + fo) = (u32x2){cvt_pk_bf16(w0 - bflo(p0), w1 - bfhi(p0)), cvt_pk_bf16(w2 - bflo(p1), w3 - bfhi(p1))}; }
        bs = wave_sum(bs);
        if (C.lane == 0) C.rbias[(l * 8 + b) * 80 + n] = bs + bias0;
    }
}
__device__ __forceinline__ void ph_n2r(const Ctx& C, int l, bool count = true) {
    for (int i = C.bid * NTHREADS + C.tid; i < MAXSLOT; i += C.nb * NTHREADS) C.slot_dst[i] = -1;
    LAS int* hist = (LAS int*)(C.lds + LDS_TAB + 1536);
    LAS float* lgp = (LAS float*)C.lds;
    LAS float* ssp = lgp + 4 * 64 * 80;
    LAS float* lg = ssp + 256;
    if (C.tid < 64) hist[C.tid] = 0;
    __syncthreads();
    const int fr = C.lane & 15, fq = C.lane >> 4;
    for (int rt = C.bid; rt < NT / 64; rt += C.nb) {
        const int rg = C.wave >> 2, kq = C.wave & 3;
        {
            const int r0 = rt * 64 + rg * 32, b = r0 >> 11;
            const bf16_t* hrow = C.H + (size_t)(r0 + fr) * D + 8 * fq + kq * 512;
            const unsigned wofs = (unsigned)__builtin_amdgcn_readfirstlane(((l * 8 + b) * 80 * D + kq * 16 * 5 * 512) * 2);
            const char* wh = (const char*)C.rwh + wofs; const char* wl = (const char*)C.rwl + wofs; const unsigned wlane = (unsigned)C.lane * 16u;
            f32x4 acc[2][5];
#pragma unroll
            for (int t = 0; t < 2; ++t)
#pragma unroll
                for (int nt = 0; nt < 5; ++nt) acc[t][nt] = (f32x4){0.f, 0.f, 0.f, 0.f};
            float ss[2] = {0.f, 0.f};
            bf16x8 hA[2], whA[5], wlA[5], hB[2], whB[5], wlB[5];
#define RT_LOAD(h_, wh_, wl_, kk) do { const int k_ = (kk) < 16 ? (kk) : 15; h_[0] = *(const bf16x8*)(hrow + 32 * k_); h_[1] = *(const bf16x8*)(hrow + 16 * D + 32 * k_); \
        _Pragma("unroll") for (int nt = 0; nt < 5; ++nt) { wh_[nt] = *(const bf16x8*)(wh + (size_t)((k_ * 5 + nt) * 1024) + wlane); wl_[nt] = *(const bf16x8*)(wl + (size_t)((k_ * 5 + nt) * 1024) + wlane); } } while (0)
#define RT_STEP(h_, wh_, wl_, kk) do { bf16x8 hc[2] = {h_[0], h_[1]}; bf16x8 whc[5], wlc[5]; _Pragma("unroll") for (int nt = 0; nt < 5; ++nt) { whc[nt] = wh_[nt]; wlc[nt] = wl_[nt]; } \
        RT_LOAD(h_, wh_, wl_, (kk) + 2); \
        _Pragma("unroll") for (int t = 0; t < 2; ++t) { const u32x4 hu = __builtin_bit_cast(u32x4, hc[t]); \
            const float h0 = bflo(hu.x), h1 = bfhi(hu.x), h2 = bflo(hu.y), h3 = bfhi(hu.y), h4 = bflo(hu.z), h5 = bfhi(hu.z), h6 = bflo(hu.w), h7 = bfhi(hu.w); \
            ss[t] += (h0 * h0 + h1 * h1) + (h2 * h2 + h3 * h3) + (h4 * h4 + h5 * h5) + (h6 * h6 + h7 * h7); } \
        _Pragma("unroll") for (int nt = 0; nt < 5; ++nt) _Pragma("unroll") for (int t = 0; t < 2; ++t) acc[t][nt] = __builtin_amdgcn_mfma_f32_16x16x32_bf16(whc[nt], hc[t], acc[t][nt], 0, 0, 0); \
        _Pragma("unroll") for (int nt = 0; nt < 5; ++nt) _Pragma("unroll") for (int t = 0; t < 2; ++t) acc[t][nt] = __builtin_amdgcn_mfma_f32_16x16x32_bf16(wlc[nt], hc[t], acc[t][nt], 0, 0, 0); } while (0)
            RT_LOAD(hA, whA, wlA, 0); RT_LOAD(hB, whB, wlB, 1);
#pragma unroll 1
            for (int ks = 0; ks < 16; ks += 2) { RT_STEP(hA, whA, wlA, ks); RT_STEP(hB, whB, wlB, ks + 1); }
#undef RT_LOAD
#undef RT_STEP
            __builtin_amdgcn_sched_barrier(0); asm volatile("s_nop 7\n\ts_nop 7" ::: "memory"); __builtin_amdgcn_sched_barrier(0);
#pragma unroll
            for (int t = 0; t < 2; ++t) { float sm = ss[t]; sm += __shfl_xor(sm, 16); sm += __shfl_xor(sm, 32);
              if (fq == 0) ssp[kq * 64 + rg * 32 + t * 16 + fr] = sm;
#pragma unroll
              for (int nt = 0; nt < 5; ++nt) *(LAS f32x4*)(lgp + (kq * 64 + rg * 32 + t * 16 + fr) * 80 + 16 * nt + 4 * fq) = acc[t][nt]; }
        }
        __syncthreads();
        { const float* rb = C.rbias + (l * 8 + ((rt * 64) >> 11)) * 80;
#pragma unroll 2
          for (int i = 0; i < 64 * 80 / NTHREADS; ++i) { const int idx = C.tid + i * NTHREADS, row = idx / 80, col = idx - row * 80;
              const float sm = (ssp[row] + ssp[64 + row]) + (ssp[128 + row] + ssp[192 + row]);
              const float a = (lgp[row * 80 + col] + lgp[(64 + row) * 80 + col]) + (lgp[(128 + row) * 80 + col] + lgp[(192 + row) * 80 + col]);
              lg[row * 80 + col] = a * rsqrtf(sm * (1.f / D) + EPS) + rb[col]; } }
        __syncthreads();
        if (C.wave < 2 && C.lane < 32) {
                const LAS float* lr = lg + (C.wave * 32 + C.lane) * 80; const int row = rt * 64 + C.wave * 32 + C.lane;
                int grp = 0; float best = -3.0e38f; float p[8];
#pragma unroll
                for (int g = 0; g < 8; ++g) { p[g] = lr[g]; if (p[g] > best) { best = p[g]; grp = g; } }
                float den = 0.f;
#pragma unroll
                for (int g = 0; g < 8; ++g) den += __expf(p[g] - best);
                const float pg = 1.f / den;
                float q[8]; int i1 = 0; float m1 = -3.0e38f;
#pragma unroll
                for (int g = 0; g < 8; ++g) { q[g] = lr[8 + grp * 8 + g]; if (q[g] > m1) { m1 = q[g]; i1 = g; } }
                int i2 = 0; float m2 = -3.0e38f;
#pragma unroll
                for (int g = 0; g < 8; ++g) if (g != i1 && q[g] > m2) { m2 = q[g]; i2 = g; }
                const float e2 = __expf(m2 - m1), inv = 1.f / (1.f + e2);
                const int ea = grp * 8 + i1, eb = grp * 8 + i2;
                C.eid[row * 2] = ea; C.eid[row * 2 + 1] = eb; C.gwt[row * 2] = pg * inv; C.gwt[row * 2 + 1] = pg * e2 * inv;
                __hip_atomic_fetch_add(&hist[ea], 1, __ATOMIC_RELAXED, __HIP_MEMORY_SCOPE_WORKGROUP); __hip_atomic_fetch_add(&hist[eb], 1, __ATOMIC_RELAXED, __HIP_MEMORY_SCOPE_WORKGROUP);
        }
        {
            int ln = C.lane; asm volatile("" : "+v"(ln));
            const int rbeg = 8 * C.wave, rend = rbeg + 8;
            const int b = (rt * 64) >> 11;
            f32x4 gsc[8], shf[8];
            { const float* g = C.n2g + (size_t)l * D; const float* shift = modptr(C, l, b, 3); const float* scale = modptr(C, l, b, 4);
#pragma unroll
              for (int j = 0; j < 8; ++j) { const int col = j * 256 + ln * 4; gsc[j] = *(const f32x4*)(g + col) * (*(const f32x4*)(scale + col) + 1.f); shf[j] = *(const f32x4*)(shift + col); } }
            f32x4 vn[8];
#pragma unroll
            for (int j = 0; j < 8; ++j) vn[j] = ld_bf16x4(C.H + (size_t)(rt * 64 + rbeg) * D + j * 256 + ln * 4);
            for (int rr = rbeg; rr < rend; ++rr) {
                const int row = rt * 64 + rr;
                f32x4 v[8], y[8];
#pragma unroll
                for (int j = 0; j < 8; ++j) v[j] = vn[j];
                { const int nrow = rt * 64 + (rr + 1 < rend ? rr + 1 : rr);
#pragma unroll
                  for (int j = 0; j < 8; ++j) vn[j] = ld_bf16x4(C.H + (size_t)nrow * D + j * 256 + ln * 4); }
                const float rstd = row_rstd(v);
#pragma unroll
                for (int j = 0; j < 8; ++j) y[j] = (v[j] * rstd) * gsc[j] + shf[j];
                store_row_bf16(y, C.A + (size_t)row * D, ln);
            }
        }
    }
    __syncthreads();
    if (count && C.tid < 64 && hist[C.tid] != 0) atomicAdd(C.ctl + cw_cnt(l, 0, C.tid), (unsigned)hist[C.tid]);
}
__device__ __forceinline__ void moe_tables(const Ctx& C, int l) {
    LAS int* tab = (LAS int*)(C.lds + LDS_TAB); LAS int* pst = (LAS int*)(C.lds + LDS_TAB + 1024);
    __syncthreads();
    if (C.wave == 0) {
        const int e = C.lane; const int cnt = (int)C.ctl[cw_cnt(l, 0, e)]; const int nbk = (cnt + 255) >> 8;
        int incl = nbk;
#pragma unroll
        for (int o = 1; o < 64; o <<= 1) { const int t = __shfl_up(incl, o); if (C.lane >= o) incl += t; }
        const int start = incl - nbk;
        pst[e] = start * 256;
        for (int q = 0; q < nbk; ++q) if (start + q < MAXBLK) tab[1 + start + q] = e;
        if (C.lane == 63) tab[0] = incl < MAXBLK ? incl : MAXBLK; }
    __syncthreads();
}
__device__ __forceinline__ void ph_disp(const Ctx& C, int l) {
    moe_tables(C, l);
    const LAS int* pst = (const LAS int*)(C.lds + LDS_TAB + 1024);
    for (int grp = C.bid * 8 + C.wave; grp < NT / 8; grp += C.nb * 8) {
        int pos = 0;
        if (C.lane < 16) { const int tok = grp * 8 + (C.lane >> 1), k = C.lane & 1;
            const int e = C.eid[tok * 2 + k];
            pos = pst[e] + (int)atomicAdd(C.ctl + cw_cnt(l, 1, e), 1u);
            C.slot_dst[pos] = tok * 2 + k; C.slot_w[pos] = C.gwt[tok * 2 + k]; }
    }
}
struct RowRaw { u32x2 h[8]; u32x2 a[8], b[8]; };
__device__ __forceinline__ void load_raw(const Ctx& C, int row, RowRaw& R) {
    const bf16_t* z0 = C.zb + (size_t)row * 2 * D; const bf16_t* z1 = z0 + D;
#pragma unroll
    for (int j = 0; j < 8; ++j) { const int col = j * 256 + C.lane * 4; R.h[j] = *(const u32x2*)(C.H + (size_t)row * D + col); R.a[j] = *(const u32x2*)(z0 + col); R.b[j] = *(const u32x2*)(z1 + col); }
}
__device__ __forceinline__ void combine_raw(const f32x4 (&m5)[8], const RowRaw& R, f32x4 (&v)[8]) {
#pragma unroll
    for (int j = 0; j < 8; ++j) { const f32x4 h = (f32x4){bflo(R.h[j].x), bfhi(R.h[j].x), bflo(R.h[j].y), bfhi(R.h[j].y)}, g = m5[j]; const u32x2 a = R.a[j], bq = R.b[j];
        v[j] = (f32x4){h.x + g.x * (bflo(a.x) + bflo(bq.x)), h.y + g.y * (bfhi(a.x) + bfhi(bq.x)), h.z + g.z * (bflo(a.y) + bflo(bq.y)), h.w + g.w * (bfhi(a.y) + bfhi(bq.y))}; }
}
__device__ __forceinline__ void ph_cmb1(const Ctx& C) {
    const int nw = C.nb * 8, per = (NT + nw - 1) / nw;
    int row = (C.bid * 8 + C.wave) * per; const int rend = row + per < NT ? row + per : NT;
    if (row >= rend) return;
    f32x4 m5[8], gsc[8], shf[8]; int rb = -1;
    RowRaw Rn; load_raw(C, row, Rn);
    for (; row < rend; ++row) {
        RowRaw Rc = Rn; load_raw(C, row + 1 < rend ? row + 1 : row, Rn);
        const int b = row >> 11;
        if (b != rb) { rb = b; const float* gate = modptr(C, 0, b, 5); const float* shift = modptr(C, 1, b, 0); const float* scale = modptr(C, 1, b, 1);
#pragma unroll
            for (int j = 0; j < 8; ++j) { const int col = j * 256 + C.lane * 4; m5[j] = *(const f32x4*)(gate + col);
                gsc[j] = *(const f32x4*)(C.n1g + D + col) * (*(const f32x4*)(scale + col) + 1.f); shf[j] = *(const f32x4*)(shift + col); } }
        f32x4 v[8]; combine_raw(m5, Rc, v);
#pragma unroll
        for (int j = 0; j < 8; ++j) *(u32x2*)(C.H + (size_t)row * D + j * 256 + C.lane * 4) = (u32x2){pk2(v[j].x, v[j].y), pk2(v[j].z, v[j].w)};
        const float rstd = row_rstd(v);
#pragma unroll
        for (int j = 0; j < 8; ++j) { const f32x4 y = (v[j] * rstd) * gsc[j] + shf[j]; *(u32x2*)(C.A + (size_t)row * D + j * 256 + C.lane * 4) = (u32x2){pk2(y.x, y.y), pk2(y.z, y.w)}; }
    }
}
template <int N>
__device__ __forceinline__ void conv_line_lds(const Ctx& C, int base, int stride, int ch0) {
    LAS unsigned char* L = C.lds;
    int tid = C.tid; asm volatile("" : "+v"(tid));
#pragma unroll
    for (int it = 0; it < N * 128 / NTHREADS; ++it) { const int q = tid + it * NTHREADS, p = q >> 7, cc = q & 127;
        const u32x4 v = *(const u32x4*)(C.ub + (size_t)(base + p * stride) * D + ch0 + cc * 8);
        *(LAS u32x4*)(L + p * 2048 + cc * 16) = v; }
    __syncthreads();
    const int ch = ch0 + 2 * tid;
    float w0[31], w1[31];
#pragma unroll
    for (int j = 0; j < 31; ++j) { const f32x2 w = *(const f32x2*)(C.wdw + j * D + ch); w0[j] = w.x; w1[j] = w.y; }
    const f32x2 bb = *(const f32x2*)(C.bdw + ch);
#pragma unroll
    for (int blk = 0; blk < N / 8; ++blk) {
        const int i0 = blk * 8;
        float x0[38], x1[38];
#pragma unroll
        for (int q = 0; q < 38; ++q) { const int p = i0 - 15 + q; const bool ok = (p >= 0 && p < N); const int pc = ok ? p : 0;
            const unsigned w = *(const LAS unsigned*)(L + pc * 2048 + tid * 4); x0[q] = ok ? bflo(w) : 0.f; x1[q] = ok ? bfhi(w) : 0.f; }
        float a0[8], a1[8];
#pragma unroll
        for (int o = 0; o < 8; ++o) { a0[o] = bb.x; a1[o] = bb.y; }
#pragma unroll
        for (int j = 0; j < 31; ++j)
#pragma unroll
            for (int o = 0; o < 8; ++o) { a0[o] += w0[j] * x0[o + j]; a1[o] += w1[j] * x1[o + j]; }
#pragma unroll
        for (int o = 0; o < 8; ++o) *(unsigned*)(C.cvb + (size_t)(base + (i0 + o) * stride) * D + ch) = pk2(a0[o], a1[o]);
    }
    __syncthreads();
}
__device__ __forceinline__ void ph_conv(const Ctx& C) {
    for (int unit = C.bid; unit < 768; unit += C.nb) {
        if (unit < 256) { const int b = unit >> 5, r = unit & 31; conv_line_lds<64>(C, b * SEQ + r * 64, 1, 0); }
        else { const int uu = unit - 256, b = uu >> 6, c = uu & 63; conv_line_lds<32>(C, b * SEQ + c, 64, 1024); }
    }
}
__device__ __forceinline__ void ph_ln(const Ctx& C) {
    const int stride = C.nb * 8; int row = C.bid * 8 + C.wave;
    f32x4 g[8], bq[8]; u32x2 an[8];
#pragma unroll
    for (int j = 0; j < 8; ++j) { const int col = j * 256 + C.lane * 4; g[j] = *(const f32x4*)(C.lng + col); bq[j] = *(const f32x4*)(C.lnb + col);
        an[j] = *(const u32x2*)(C.cvb + (size_t)(row < NT ? row : NT - 1) * D + col); }
    for (; row < NT; row += stride) {
        f32x4 v[8]; float s = 0.f;
#pragma unroll
        for (int j = 0; j < 8; ++j) { const u32x2 a = an[j]; v[j] = (f32x4){bflo(a.x), bfhi(a.x), bflo(a.y), bfhi(a.y)}; s += (v[j].x + v[j].y) + (v[j].z + v[j].w); }
        { const int nr = row + stride < NT ? row + stride : row;
#pragma unroll
          for (int j = 0; j < 8; ++j) an[j] = *(const u32x2*)(C.cvb + (size_t)nr * D + j * 256 + C.lane * 4); }
        const float mean = wave_sum(s) * (1.f / D); float s2 = 0.f;
#pragma unroll
        for (int j = 0; j < 8; ++j) { v[j] = v[j] - mean; s2 += (v[j].x * v[j].x + v[j].y * v[j].y) + (v[j].z * v[j].z + v[j].w * v[j].w); }
        const float rstd = rsqrtf(wave_sum(s2) * (1.f / D) + EPS);
#pragma unroll
        for (int j = 0; j < 8; ++j) { const f32x4 y = v[j] * rstd * g[j] + bq[j];
            *(u32x2*)(C.A + (size_t)row * D + j * 256 + C.lane * 4) = (u32x2){pk2(silu(y.x), silu(y.y)), pk2(silu(y.z), silu(y.w))}; }
    }
}
__device__ __forceinline__ void ph_final(const Ctx& C) {
    const int nw = C.nb * 8, per = (NT + nw - 1) / nw;
    int row = (C.bid * 8 + C.wave) * per; const int rend = row + per < NT ? row + per : NT;
    if (row >= rend) return;
    f32x4 m5[8], fg[8]; int rb = -1;
#pragma unroll
    for (int j = 0; j < 8; ++j) fg[j] = *(const f32x4*)(C.fing + j * 256 + C.lane * 4);
    RowRaw Rn; load_raw(C, row, Rn);
    for (; row < rend; ++row) {
        RowRaw Rc = Rn; load_raw(C, row + 1 < rend ? row + 1 : row, Rn);
        const int b = row >> 11;
        if (b != rb) { rb = b; const float* gate = modptr(C, 1, b, 5);
#pragma unroll
            for (int j = 0; j < 8; ++j) m5[j] = *(const f32x4*)(gate + j * 256 + C.lane * 4); }
        f32x4 v[8]; combine_raw(m5, Rc, v);
        const float rstd = row_rstd(v);
#pragma unroll
        for (int j = 0; j < 8; ++j) *(f32x4*)(C.out + (size_t)row * D + j * 256 + C.lane * 4) = v[j] * rstd * fg[j];
    }
}

constexpr int NPHASE = 21;
struct Args { const float* in[26]; float* out; unsigned char* ws; int ph_lo, ph_hi; };
__global__ void __launch_bounds__(NTHREADS, 2) fwd(Args args) {
    extern __shared__ __attribute__((aligned(16))) unsigned char lds_raw[];
    Ctx C;
    C.lds = (LAS unsigned char*)lds_raw;
    C.tid = threadIdx.x; C.lane = C.tid & 63; C.wave = __builtin_amdgcn_readfirstlane(C.tid >> 6); C.bid = blockIdx.x; C.nb = gridDim.x;
    C.vc = (C.nb % 8 == 0) ? (C.bid % 8) * (C.nb / 8) + C.bid / 8 : C.bid;
    const float* const* in = args.in;
    C.x = in[0]; C.c = in[1]; C.ctxx = in[2]; C.c_ctx = in[3]; C.ada_w = in[4]; C.ada_b = in[5]; C.n1g = in[6]; C.n2g = in[7]; C.w_in = in[8]; C.hlb = in[9]; C.onorm = in[10]; C.w_out = in[11];
    C.pw1 = in[12]; C.wdw = in[13]; C.bdw = in[14]; C.lng = in[15]; C.lnb = in[16]; C.pw2 = in[17]; C.wr1 = in[18]; C.br1 = in[19]; C.wr2 = in[20]; C.br2 = in[21]; C.wg = in[22]; C.wu = in[23]; C.wd = in[24]; C.fing = in[25];
    C.out = args.out;
    unsigned char* ws = args.ws;
    C.ctl = (unsigned*)(ws + WS_CTL); C.mod = (float*)(ws + WS_MOD); C.lbt = (float*)(ws + WS_LB); C.rwh = (bf16_t*)(ws + WS_RWH); C.rwl = (bf16_t*)(ws + WS_RWL); C.rbias = (float*)(ws + WS_RBIAS);
    C.eid = (int*)(ws + WS_ROUTE); C.gwt = (float*)(ws + WS_ROUTE + 131072); C.slot_dst = (int*)(ws + WS_ROUTE + 262144); C.slot_w = (float*)(ws + WS_ROUTE + 262144 + 196608);
    C.modp = (float*)(ws + WS_MODP);
    C.Win = (bf16_t*)(ws + WS_WIN); C.Wout = (bf16_t*)(ws + WS_WOUT); C.Wpw1 = (bf16_t*)(ws + WS_WPW1); C.Wpw2 = (bf16_t*)(ws + WS_WPW2); C.Wgu = (bf16_t*)(ws + WS_WGU); C.Wd = (bf16_t*)(ws + WS_WD);
    C.H = (bf16_t*)(ws + WS_H); C.A = (bf16_t*)(ws + WS_A);
    C.qs = (bf16_t*)(ws + WS_QS); C.gs = (bf16_t*)(ws + WS_GS); C.vv = (bf16_t*)(ws + WS_VV); C.kf = (f16_t*)(ws + WS_KF); C.kb = (f16_t*)(ws + WS_KB); C.ofw = (bf16_t*)(ws + WS_OFW); C.obw = (bf16_t*)(ws + WS_OBW);
    C.Xg = (bf16_t*)(ws + WS_XG); C.Hb = (bf16_t*)(ws + WS_HB); C.zb = (bf16_t*)(ws + WS_ZB); C.ub = (bf16_t*)(ws + WS_UB); C.cvb = (bf16_t*)(ws + WS_CV);

    volatile LAS unsigned* misc = (volatile LAS unsigned*)(C.lds + LDS_MISC);
    if (C.tid < 4) misc[C.tid] = 0u;
    __syncthreads();
    const int lo = args.ph_lo, hi = args.ph_hi;
    XcdBarrier bar; bar.bar = C.ctl + CW_BAR; bar.x = 0; bar.st = misc;
    if (hi - lo > 1) bar = xcd_barrier_post(C.ctl + CW_BAR, misc);
#ifndef PH_MASK
#define PH_MASK 0xFFFFFFFFu
#endif
#define IN(k) (((PH_MASK >> (k)) & 1u) && lo <= (k) && (k) < hi)
#define SEAM(k) do { if (IN(k) && IN((k) + 1)) xcd_barrier(bar); } while (0)
#ifndef DUP_MASK
#define DUP_MASK 0u
#endif
#define DUP(k) ((DUP_MASK >> (k)) & 1u)

#if DIAG_CK
#define CK(slot, p, nb_) cksum(C, slot, p, nb_)
#else
#define CK(slot, p, nb_) do {} while (0)
#endif
#define PHASE(k, ...) do { if (IN(k)) { __VA_ARGS__; if (DUP(k)) { __syncthreads(); __VA_ARGS__; } } SEAM(k); } while (0)
    PHASE(0, { ph_pre(C); ph_pre_cvt(C); });
    PHASE(1, ph_modr(C));
    PHASE(2, { CK(1, C.mod, 2 * 9 * 6 * D * 4); ph_n1_l0(C); ph_rprep(C); });
    PHASE(3, { const int q = (11 * (C.bid & 7)) >> 3; EpiProj E{C.qs, C.gs, C.vv, C.kf, C.kb, C.lbt};
        { ProjSched S{C.nb, C.bid, 0, q}; gemm_run(C.lds, C.A, C.Win, D, S, E); }
        ph_cvt_moe(C, C.bid, 12288 / C.nb, C.nb);
        { ProjSched S{C.nb, C.bid, q, 11}; gemm_run(C.lds, C.A, C.Win, D, S, E); } });
#if GOLD_SCAN
    PHASE(4, ph_scan_gold(C));
#else
    PHASE(4, { CK(3, C.qs, (size_t)NT * D * 2); CK(25, C.gs, (size_t)NT * D * 2); CK(26, C.vv, (size_t)NR * D * 2); CK(27, C.kf, (size_t)NR * D * 2); CK(28, C.kb, (size_t)NR * D * 2); ph_scan_fast(C); });
#endif
    PHASE(5, { CK(4, C.ofw, (size_t)NT * D * 2); CK(29, C.obw, (size_t)NT * D * 2); ph_rdprep(C); });
    PHASE(6, { CK(5, C.A, (size_t)NT * D * 2); DenseSched S{64, 8, C.nb, C.bid}; EpiRes<false> E{C.x, C.H, modptr(C, 0, 0, 2)}; gemm_run(C.lds, C.A, C.Wout, D, S, E); });
    if (IN(7)) { CK(6, C.H, (size_t)NT * D * 2); ph_n2r(C, 0); if (DUP(7)) { __syncthreads(); ph_n2r(C, 0, false); } } SEAM(7);
    PHASE(8, { CK(7, C.A, (size_t)NT * D * 2); CK(30, C.eid, NT * 2 * 4); CK(31, C.gwt, NT * 2 * 4); ph_disp(C, 0); });
    PHASE(9, { moe_tables(C, 0); MoeSched S{(const LAS int*)(C.lds + LDS_TAB), 4, C.nb, C.vc, 0}; EpiSwiGLU E{C.Hb}; gemm_run<true, true>(C.lds, C.A, C.Wgu, D, S, E, C.slot_dst); });
    PHASE(10, { moe_tables(C, 0); MoeSched S{(const LAS int*)(C.lds + LDS_TAB), 8, C.nb, C.vc, 0}; EpiDown E{C.zb, C.slot_dst, C.slot_w}; gemm_run(C.lds, C.Hb, C.Wd, MHID, S, E); });
    PHASE(11, { CK(10, C.zb, (size_t)NT * 2 * D * 2); ph_cmb1(C); });
    PHASE(12, { CK(11, C.H, (size_t)NT * D * 2); CK(32, C.A, (size_t)NT * D * 2); const int q = (4 * (C.bid & 7)) >> 3; EpiConvGLU E{C.ub};
        { DenseSched S{64, 16, C.nb, C.bid, 0, q}; gemm_run(C.lds, C.A, C.Wpw1, D, S, E); }
        ph_cvt_moe(C, 12288 + C.bid, 12288 / C.nb, C.nb);
        { DenseSched S{64, 16, C.nb, C.bid, q, 4}; gemm_run(C.lds, C.A, C.Wpw1, D, S, E); } });
    PHASE(13, { CK(12, C.ub, (size_t)NT * D * 2); ph_conv(C); });
    PHASE(14, { CK(13, C.cvb, (size_t)NT * D * 2); ph_ln(C); });
    PHASE(15, { CK(14, C.A, (size_t)NT * D * 2); DenseSched S{64, 8, C.nb, C.bid}; EpiRes<true> E{C.H, C.H, modptr(C, 1, 0, 2)}; gemm_run(C.lds, C.A, C.Wpw2, D, S, E); });
    if (IN(16)) { CK(15, C.H, (size_t)NT * D * 2); ph_n2r(C, 1); if (DUP(16)) { __syncthreads(); ph_n2r(C, 1, false); } } SEAM(16);
    PHASE(17, { CK(16, C.A, (size_t)NT * D * 2); CK(33, C.eid, NT * 2 * 4); CK(34, C.gwt, NT * 2 * 4); ph_disp(C, 1); });
    PHASE(18, { moe_tables(C, 1); MoeSched S{(const LAS int*)(C.lds + LDS_TAB), 4, C.nb, C.vc, 64 * 4}; EpiSwiGLU E{C.Hb}; gemm_run<true, true>(C.lds, C.A, C.Wgu, D, S, E, C.slot_dst); });
    PHASE(19, { moe_tables(C, 1); MoeSched S{(const LAS int*)(C.lds + LDS_TAB), 8, C.nb, C.vc, 64 * 8}; EpiDown E{C.zb, C.slot_dst, C.slot_w}; gemm_run(C.lds, C.Hb, C.Wd, MHID, S, E); });
    PHASE(20, { CK(19, C.zb, (size_t)NT * 2 * D * 2); ph_final(C); });
#if DIAG_CK
    if (hi - lo > 1) {
        xcd_barrier(bar);
        CK(20, C.out, (size_t)NT * D * 4);
        xcd_barrier(bar);
        unsigned* st = (unsigned*)(args.ws + WS_STICKY);
        LAS unsigned* kbad = (LAS unsigned*)(C.lds + LDS_TAB + 2048);
        if (C.tid == 0) { unsigned bad = 0u;
            if (st[0] == 0x5EEDC0DEu) { const int pri[30] = {22, 23, 24, 1, 2, 21, 3, 25, 26, 27, 28, 4, 29, 5, 6, 7, 30, 31, 10, 11, 32, 12, 13, 14, 15, 16, 33, 34, 19, 20};
                for (int q = 29; q >= 0; --q) { const int k = pri[q]; if (st[1 + k] != C.ctl[CW_CK + k]) bad = (unsigned)k; } }
            kbad[0] = bad; }
        __syncthreads();
        const unsigned bad = kbad[0];
        if (bad) { const float f = 1.f + 0.02f * (float)bad;
            for (size_t i = (size_t)C.bid * NTHREADS + C.tid; i < (size_t)NT * D / 4; i += (size_t)C.nb * NTHREADS) { f32x4 v = ((f32x4*)C.out)[i]; ((f32x4*)C.out)[i] = v * f; } }
        xcd_barrier(bar);
        if (C.bid == 0 && C.tid < 64) { st[1 + C.tid] = C.ctl[CW_CK + C.tid]; if (C.tid == 0) st[0] = 0x5EEDC0DEu; }
    }
#endif
#undef PHASE
#undef IN
#undef SEAM
}

extern "C" void kernel_launch(void* const* d_in, const int* in_sizes, int n_in, void* d_out, int out_size, void* d_ws, size_t ws_size, hipStream_t stream) {
    static int grid = 0;
    if (grid == 0) {
        if (n_in != 26 || in_sizes[0] != NT * D || out_size != NT * D || ws_size < WS_END) { fprintf(stderr, "kernel_launch: unexpected shapes / workspace (n_in %d, ws %zu < %zu)\n", n_in, ws_size, (size_t)WS_END); grid = -1; return; }
        int dev = 0, cus = 0;
        if (hipGetDevice(&dev) != hipSuccess || hipDeviceGetAttribute(&cus, hipDeviceAttributeMultiprocessorCount, dev) != hipSuccess) { grid = -1; return; }
        if (hipFuncSetAttribute((const void*)fwd, hipFuncAttributeMaxDynamicSharedMemorySize, LDS_BYTES) != hipSuccess) { fprintf(stderr, "kernel_launch: hipFuncSetAttribute failed\n"); grid = -1; return; }
        int per_cu = 0;
        if (hipOccupancyMaxActiveBlocksPerMultiprocessor(&per_cu, (const void*)fwd, NTHREADS, LDS_BYTES) != hipSuccess || per_cu < 1) fprintf(stderr, "kernel_launch: occupancy query reports %d blocks per CU\n", per_cu);
        (void)hipGetLastError();
        grid = cus;
    }
    if (grid < 0) return;
    (void)hipMemsetAsync((char*)d_ws + WS_CTL, 0, CTL_BYTES, stream);
    Args a{};
    for (int i = 0; i < 26; ++i) a.in[i] = (const float*)d_in[i];
    a.out = (float*)d_out; a.ws = (unsigned char*)d_ws;
#if MK_MULTI
    for (int k = 0; k < NPHASE; ++k) { a.ph_lo = k; a.ph_hi = k + 1; hipLaunchKernelGGL(fwd, dim3(grid), dim3(NTHREADS), LDS_BYTES, stream, a); }
#else
    a.ph_lo = 0; a.ph_hi = NPHASE;
    hipLaunchKernelGGL(fwd, dim3(grid), dim3(NTHREADS), LDS_BYTES, stream, a);
#endif
}
```

```cpp
#include <hip/hip_runtime.h>
#include <cstdio>
#include <cstdint>

#ifndef MK_MULTI
#define MK_MULTI 0
#endif
#ifndef GOLD_GEMM
#define GOLD_GEMM 0
#endif
#ifndef GOLD_SCAN
#define GOLD_SCAN 0
#endif

#define LAS __attribute__((address_space(3)))
typedef unsigned short bf16_t;
typedef _Float16 f16_t;
typedef short bf16x8 __attribute__((ext_vector_type(8)));
typedef float f32x4 __attribute__((ext_vector_type(4)));
typedef float f32x2 __attribute__((ext_vector_type(2)));
typedef unsigned u32x4 __attribute__((ext_vector_type(4)));
typedef unsigned u32x2 __attribute__((ext_vector_type(2)));

constexpr int D = 2048, NBATCH = 8, SEQ = 2048, NT = NBATCH * SEQ, CTXL = 256, NC = NBATCH * CTXL, NR = NT + NC;
constexpr int NHEAD = 16, HK = 128;
constexpr int NEXP = 64, MHID = 512, MAXBLK = 192, MAXSLOT = MAXBLK * 256;
constexpr float EPS = 1e-6f;
constexpr int NTHREADS = 512;

constexpr size_t MiB = 1u << 20;
constexpr size_t WS_CTL = 0, CTL_BYTES = 1 * MiB;
constexpr size_t WS_MOD = 1 * MiB;
constexpr size_t WS_LB = 2 * MiB;
constexpr size_t WS_ROUTE = 3 * MiB;
constexpr size_t WS_MODP = 5 * MiB;
constexpr size_t WS_WIN = 32 * MiB;
constexpr size_t WS_WOUT = 72 * MiB;
constexpr size_t WS_WPW1 = 80 * MiB;
constexpr size_t WS_WPW2 = 96 * MiB;
constexpr size_t WS_WGU = 104 * MiB;
constexpr size_t WS_WD = 616 * MiB;
constexpr size_t WS_H = 872 * MiB;
constexpr size_t WS_A = 1000 * MiB;
constexpr size_t WS_QS = 1072 * MiB, WS_GS = 1136 * MiB, WS_VV = 1200 * MiB, WS_KF = 1272 * MiB, WS_KB = 1344 * MiB, WS_OFW = 1416 * MiB, WS_OBW = 1480 * MiB;
constexpr size_t WS_XG = 1072 * MiB;
constexpr size_t WS_HB = 1264 * MiB;
constexpr size_t WS_ZB = 1312 * MiB;
constexpr size_t WS_UB = 1440 * MiB, WS_CV = 1504 * MiB;
constexpr size_t WS_RWH = 1568 * MiB, WS_RWL = 1574 * MiB;
constexpr size_t WS_RBIAS = 2 * MiB + 65536;
constexpr size_t WS_END = 1582 * MiB;
constexpr int CW_BAR = 4096;
constexpr int CW_CNT = 16384;
__host__ __device__ constexpr int cw_cnt(int l, int which, int e) { return CW_CNT + (((l * 2 + which) * 64 + e) * 64); }

constexpr int LDS_TAB = 131072;
constexpr int LDS_MISC = 131072 + 4096;
constexpr int LDS_BYTES = 147456;

__device__ __forceinline__ float wave_sum(float v) {
#pragma unroll
    for (int o = 1; o < 64; o <<= 1) v += __shfl_xor(v, o);
    return v;
}
__device__ __forceinline__ unsigned f2bf(float f) { unsigned u = __builtin_bit_cast(unsigned, f); return (u + 0x7fffu + ((u >> 16) & 1u)) >> 16; }
typedef __bf16 bf16x2_t __attribute__((ext_vector_type(2)));
__device__ __forceinline__ unsigned pk2(float lo, float hi) { const bf16x2_t r = __builtin_convertvector((f32x2){lo, hi}, bf16x2_t); return __builtin_bit_cast(unsigned, r); }
__device__ __forceinline__ float bflo(unsigned w) { return __builtin_bit_cast(float, w << 16); }
__device__ __forceinline__ float bfhi(unsigned w) { return __builtin_bit_cast(float, w & 0xffff0000u); }
__device__ __forceinline__ float bf2f(bf16_t b) { return __builtin_bit_cast(float, (unsigned)b << 16); }
__device__ __forceinline__ float sigm(float x) { return __builtin_amdgcn_rcpf(1.f + __builtin_amdgcn_exp2f(-1.44269504f * x)); }
__device__ __forceinline__ float silu(float x) { return x * __builtin_amdgcn_rcpf(1.f + __builtin_amdgcn_exp2f(-1.44269504f * x)); }

#define XB_TMO      128
#define XB_XCNT(j)  (256  + 64 * (j))
#define XB_XSUB(j)  (1280 + 64 * (j))
#define XB_XGEN(j)  (2304 + 64 * (j))
#define XB_TOP      3328
#define XB_TOPGEN   3392
#define XCD_BAR_WORDS 3456
#define XB_SPIN_CAP (1u << 18)
__device__ __forceinline__ unsigned xb_ld(unsigned* p)              { return __hip_atomic_load(p, __ATOMIC_RELAXED, __HIP_MEMORY_SCOPE_AGENT); }
__device__ __forceinline__ unsigned xb_add(unsigned* p, unsigned v) { return __hip_atomic_fetch_add(p, v, __ATOMIC_RELAXED, __HIP_MEMORY_SCOPE_AGENT); }
__device__ __forceinline__ unsigned xb_xcc_id() { return (unsigned)__builtin_amdgcn_s_getreg((3 << 11) | 20) & 0xFu; }
#define XB_SPIN(cond, bar) do { unsigned _sp = 0; while (cond) { __builtin_amdgcn_s_sleep(1); \
    if ((++_sp & 255u) == 0u) { if (xb_ld(&(bar)[XB_TMO])) break; if (_sp > XB_SPIN_CAP) { atomicAdd(&(bar)[XB_TMO], 1u); break; } } } } while (0)
struct XcdBarrier { unsigned* bar; unsigned x; volatile LAS unsigned* st; };
__device__ __forceinline__ XcdBarrier xcd_barrier_post(unsigned* bar, volatile LAS unsigned* st) {
    XcdBarrier b; b.bar = bar; b.x = xb_xcc_id(); b.st = st;
    if (threadIdx.x == 0) (void)xb_add(&bar[XB_XCNT(b.x)], 1u);
    return b;
}
__device__ __forceinline__ void xcd_barrier_complete(unsigned* bar, unsigned x, unsigned& nloc, unsigned& nx) {
    const unsigned G = gridDim.x * gridDim.y * gridDim.z;
    unsigned sum, cnt, mine, sp = 0u;
    for (;;) {
        sum = 0u; cnt = 0u; mine = 0u;
#pragma unroll
        for (unsigned j = 0; j < 16; ++j) { const unsigned c = xb_ld(&bar[XB_XCNT(j)]); sum += c; cnt += (c > 0u) ? 1u : 0u; mine = (j == x) ? c : mine; }
        if (sum == G) break;
        __builtin_amdgcn_s_sleep(1);
        if ((++sp & 255u) == 0u) { if (xb_ld(&bar[XB_TMO])) break; if (sp > XB_SPIN_CAP) { atomicAdd(&bar[XB_TMO], 1u); break; } }
    }
    nloc = mine > 0u ? mine : 1u; nx = cnt > 0u ? cnt : 1u;
}
__device__ __forceinline__ void xcd_barrier(const XcdBarrier& b) {
    asm volatile("s_waitcnt vmcnt(0)" ::: "memory");
    __syncthreads();
    if (threadIdx.x == 0) {
        unsigned* bar = b.bar;
        __builtin_amdgcn_s_waitcnt(0);
        unsigned nloc = b.st[0], nx = b.st[1];
        if (nloc == 0u) { xcd_barrier_complete(bar, b.x, nloc, nx); b.st[0] = nloc; b.st[1] = nx; }
        const unsigned old = xb_add(&bar[XB_XSUB(b.x)], 1u);
        const unsigned gen = old / nloc;
        if (old + 1u == (gen + 1u) * nloc) {
            __builtin_amdgcn_fence(__ATOMIC_RELEASE, "agent");
            asm volatile("s_waitcnt vmcnt(0)" ::: "memory");
            const unsigned og = xb_add(&bar[XB_TOP], 1u);
            const unsigned tg = og / nx;
            if (og + 1u == (tg + 1u) * nx) xb_add(&bar[XB_TOPGEN], 1u);
            else XB_SPIN(xb_ld(&bar[XB_TOPGEN]) == tg, bar);
            __builtin_amdgcn_fence(__ATOMIC_ACQUIRE, "agent");
            xb_add(&bar[XB_XGEN(b.x)], 1u);
            asm volatile("s_waitcnt vmcnt(0)" ::: "memory");
        } else {
            XB_SPIN(xb_ld(&bar[XB_XGEN(b.x)]) == gen, bar);
            __builtin_amdgcn_fence(__ATOMIC_ACQUIRE, "agent");
            asm volatile("s_waitcnt vmcnt(0)" ::: "memory");
        }
    }
    __syncthreads();
}

struct Ctx {
    LAS unsigned char* lds;
    int tid, lane, wave, bid, nb, vc;
    const float *x, *c, *ctxx, *c_ctx, *ada_w, *ada_b, *n1g, *n2g, *w_in, *hlb, *onorm, *w_out, *pw1, *wdw, *bdw, *lng, *lnb, *pw2, *wr1, *br1, *wr2, *br2, *wg, *wu, *wd, *fing;
    float* out;
    unsigned* ctl; float* mod; float* lbt; bf16_t *rwh, *rwl; float* rbias; int* eid; float* gwt; int* slot_dst; float* slot_w; float* modp;
    bf16_t *Win, *Wout, *Wpw1, *Wpw2, *Wgu, *Wd;
    bf16_t* H; bf16_t* A; bf16_t *qs, *gs, *vv; f16_t *kf, *kb; bf16_t *ofw, *obw; bf16_t *Xg, *Hb, *zb, *ub, *cvb;
};
__device__ __forceinline__ const float* modptr(const Ctx& C, int l, int r, int chunk) { return C.mod + ((size_t)(l * 9 + r) * 6 + chunk) * D; }


#ifndef DIAG_CK
#define DIAG_CK 0
#endif
#if DIAG_CK
constexpr int CW_CK = 40000;
constexpr size_t WS_STICKY = 1580 * MiB;
__device__ __forceinline__ void cksum(const Ctx& C, int slot, const void* p, size_t nbytes) {
    const u32x4* q = (const u32x4*)p; const size_t n = nbytes / 16; unsigned acc = 0;
    for (size_t i = (size_t)C.bid * NTHREADS + C.tid; i < n; i += (size_t)C.nb * NTHREADS) { const u32x4 v = q[i]; acc += v.x + v.y * 3u + v.z * 5u + v.w * 7u; }
#pragma unroll
    for (int o = 1; o < 64; o <<= 1) acc += __shfl_xor(acc, o);
    if (C.lane == 0) atomicAdd(C.ctl + CW_CK + slot, acc);
}
#endif
struct Unit { int pm, pn, pj; };
constexpr int BM = 256, BK = 64, HALF = 128, HTB = HALF * BK * 2, NXCD = 8, WGM = 4;
__host__ __device__ __forceinline__ int lds_byte(int r, int c) { const int st = (r >> 4) * 2 + (c >> 5), rr = r & 15, cc = c & 31, ob = rr * 64 + cc * 2; return st * 1024 + (ob ^ (((ob >> 9) & 1) << 5)); }
__host__ __device__ __forceinline__ void stage_rc(int b, int& R, int& C) { const int st = b / 1024, sb = b % 1024, swz = sb ^ (((sb >> 9) & 1) << 5); R = (st >> 1) * 16 + swz / 64; C = (st & 1) * 32 + (swz % 64) / 2; }
__host__ __device__ __forceinline__ int perm32(int rho) { const int n = rho >> 4, i = rho & 15; return 8 * (i >> 2) + 4 * n + (i & 3); }

__device__ __forceinline__ void static_tile(long L, int nM, int nN, int& pm, int& pn) {
    const int nwg = nM * nN; int wgid = (int)L;
    { const int q = nwg / NXCD, r = nwg % NXCD, xcd = wgid % NXCD, off = wgid / NXCD; wgid = (xcd < r ? xcd * (q + 1) : r * (q + 1) + (xcd - r) * q) + off; }
    const int nig = WGM * nN, gid = wgid / nig, fm = gid * WGM, gsz = (nM - fm) < WGM ? (nM - fm) : WGM;
    pm = fm + ((wgid % nig) % gsz); pn = (wgid % nig) / gsz;
}
struct DenseSched {
    int nM, nN, G, c, r0 = 0, r1 = 1 << 20;
    __device__ __forceinline__ bool next(int i, Unit& u) const {
        if (r0 + i >= r1) return false;
        const long L = (long)(r0 + i) * G + c; if (L >= (long)nM * nN) return false;
        static_tile(L, nM, nN, u.pm, u.pn); u.pj = u.pn; return true;
    }
};
struct ProjSched {
    int G, c, r0, r1;
    __device__ __forceinline__ bool next(int i, Unit& u) const {
        if (r0 + i >= r1) return false;
        const long L = (long)(r0 + i) * G + c;
        if (L < 2560) { static_tile(L, 64, 40, u.pm, u.pn); u.pj = u.pn; return true; }
        const int r = (int)(L - 2560); if (r >= 192) return false;
        u.pm = 64 + (r & 7); u.pn = 8 + (r >> 3); u.pj = u.pn; return true;
    }
};
struct MoeSched {
    const LAS int* tab; int nN, G, vc, wbase;
    __device__ __forceinline__ bool next(int i, Unit& u) const {
        const int L = i * G + vc; const int nblk = tab[0]; if (L >= nblk * nN) return false;
        const int blk = L / nN, j = L - blk * nN; u.pm = blk; u.pn = wbase + tab[1 + blk] * nN + j; u.pj = j; return true;
    }
};

__device__ __forceinline__ unsigned cvt_pk_bf16(float lo, float hi) { const bf16x2_t r = __builtin_convertvector((f32x2){lo, hi}, bf16x2_t); return __builtin_bit_cast(unsigned, r); }
__device__ __forceinline__ u32x4 pack8(const float (&v)[8]) { u32x4 w; w.x = cvt_pk_bf16(v[0], v[1]); w.y = cvt_pk_bf16(v[2], v[3]); w.z = cvt_pk_bf16(v[4], v[5]); w.w = cvt_pk_bf16(v[6], v[7]); return w; }

struct EpiProj {
    static constexpr bool GLU = false, ROWCTX = false, COLCTX = true, BASE = false;
    bf16_t *qs, *gs, *vv; f16_t *kf, *kb; const float* lbt;
    __device__ __forceinline__ void colctx(int row, int col, float (&c)[8]) const {
        const int grp = col >> 11, cc = col & 2047;
        if (grp == 2 || grp == 3) { const float* lb = lbt + (grp == 3 ? D : 0) + cc; const f32x4 l0 = *(const f32x4*)lb, l1 = *(const f32x4*)(lb + 4);
            c[0] = 1.f - l0.x; c[1] = 1.f - l0.y; c[2] = 1.f - l0.z; c[3] = 1.f - l0.w; c[4] = 1.f - l1.x; c[5] = 1.f - l1.y; c[6] = 1.f - l1.z; c[7] = 1.f - l1.w; }
        else {
#pragma unroll
            for (int j = 0; j < 8; ++j) c[j] = 0.f; }
    }
    __device__ __forceinline__ void store_cc(int row, int col, const float (&v)[8], const float (&c)[8]) const {
        const int grp = col >> 11, cc = col & 2047; const size_t o = (size_t)row * D + cc;
        if (grp == 0 || grp == 4) { float t[8];
#pragma unroll
            for (int j = 0; j < 8; ++j) t[j] = silu(v[j]);
            *(u32x4*)((grp == 0 ? qs : gs) + o) = pack8(t);
        } else if (grp == 1) { *(u32x4*)(vv + o) = pack8(v); }
        else { f16_t* dst = (grp == 3 ? kb : kf) + o;
            typedef _Float16 h8 __attribute__((ext_vector_type(8))); h8 hv;
#pragma unroll
            for (int j = 0; j < 8; ++j) hv[j] = (_Float16)(c[j] * sigm(-v[j]));
            *(h8*)dst = hv; }
    }
    __device__ __forceinline__ void store(int row, int col, const float (&v)[8]) const { float c[8]; colctx(row, col, c); store_cc(row, col, v, c); }
};
template <bool BASE_BF16>
struct EpiRes {
    static constexpr bool GLU = false, ROWCTX = false, COLCTX = true, BASE = true;
    const void* base; bf16_t* out; const float* gate;
    __device__ __forceinline__ void colctx(int row, int col, float (&c)[8]) const {
        const float* g = gate + (size_t)(row >> 11) * 6 * D + col; const f32x4 g0 = *(const f32x4*)g, g1 = *(const f32x4*)(g + 4);
        c[0] = g0.x; c[1] = g0.y; c[2] = g0.z; c[3] = g0.w; c[4] = g1.x; c[5] = g1.y; c[6] = g1.z; c[7] = g1.w; }
    __device__ __forceinline__ void loadbase(int row, int col, f32x4 (&b)[2]) const { const size_t o = (size_t)row * D + col;
        if constexpr (BASE_BF16) { const u32x4 w = *(const u32x4*)((const bf16_t*)base + o); b[0] = (f32x4){bflo(w.x), bfhi(w.x), bflo(w.y), bfhi(w.y)}; b[1] = (f32x4){bflo(w.z), bfhi(w.z), bflo(w.w), bfhi(w.w)}; }
        else { b[0] = *(const f32x4*)((const float*)base + o); b[1] = *(const f32x4*)((const float*)base + o + 4); } }
    __device__ __forceinline__ void store_cb(int row, int col, const float (&v)[8], const float (&c)[8], const f32x4 (&b)[2]) const {
        const float t[8] = {b[0].x + c[0] * v[0], b[0].y + c[1] * v[1], b[0].z + c[2] * v[2], b[0].w + c[3] * v[3], b[1].x + c[4] * v[4], b[1].y + c[5] * v[5], b[1].z + c[6] * v[6], b[1].w + c[7] * v[7]};
        *(u32x4*)(out + (size_t)row * D + col) = pack8(t);
    }
    __device__ __forceinline__ void store(int row, int col, const float (&v)[8]) const { float c[8]; f32x4 b[2]; colctx(row, col, c); loadbase(row, col, b); store_cb(row, col, v, c, b); }
};
struct EpiSwiGLU {
    static constexpr bool GLU = true, ROWCTX = false, COLCTX = false, BASE = false;
    bf16_t* Hb;
    __device__ __forceinline__ void glu(int row, int colh, const float (&g)[8], const float (&u)[8]) const {
        float t[8];
#pragma unroll
        for (int j = 0; j < 8; ++j) t[j] = silu(g[j]) * u[j];
        *(u32x4*)(Hb + (size_t)row * MHID + colh) = pack8(t);
    }
};
struct EpiDown {
    static constexpr bool GLU = false, ROWCTX = true, COLCTX = false, BASE = false;
    bf16_t* zb; const int* slot_dst; const float* slot_w;
    __device__ __forceinline__ void rowctx(int row, int& dst, float& w) const { dst = slot_dst[row]; w = slot_w[row]; }
    __device__ __forceinline__ void store_ctx(int dst, float w, int col, const float (&v)[8]) const {
        if (dst < 0) return;
        float t[8];
#pragma unroll
        for (int j = 0; j < 8; ++j) t[j] = w * v[j];
        *(u32x4*)(zb + (size_t)dst * D + col) = pack8(t);
    }
    __device__ __forceinline__ void store(int row, int col, const float (&v)[8]) const { int dst; float w; rowctx(row, dst, w); store_ctx(dst, w, col, v); }
};
struct EpiConvGLU {
    static constexpr bool GLU = true, ROWCTX = false, COLCTX = false, BASE = false;
    bf16_t* ub;
    __device__ __forceinline__ void glu(int row, int colh, const float (&a)[8], const float (&g)[8]) const {
        float t[8];
#pragma unroll
        for (int j = 0; j < 8; ++j) t[j] = a[j] * sigm(g[j]);
        *(u32x4*)(ub + (size_t)row * D + colh) = pack8(t);
    }
};

template <bool GATHER = false, class Epi, class Sched>
__device__ __forceinline__ void gemm_gold(LAS unsigned char* lds, const bf16_t* A, const bf16_t* Bt, int K, const Sched& S, const Epi& E, const int* rowmap = nullptr) {
    constexpr int LDG = 260;
    LAS float* As = (LAS float*)lds; LAS float* Bs = As + 16 * LDG;
    const int tid = threadIdx.x, ty = tid >> 4, tx = tid & 15, lr = tid >> 1, lk = (tid & 1) * 8;
    Unit u;
    for (int it = 0; S.next(it, u); ++it) {
        float acc0[8][8], acc1[8][8];
#pragma unroll
        for (int i = 0; i < 8; ++i)
#pragma unroll
            for (int j = 0; j < 8; ++j) { acc0[i][j] = 0.f; acc1[i][j] = 0.f; }
        size_t arow = (size_t)u.pm * 256 + lr; if constexpr (GATHER) { const int d_ = rowmap[arow]; arow = d_ < 0 ? 0 : (size_t)(d_ >> 1); }
        const bf16_t* ap = A + arow * K + lk;
        const bf16_t* bp = Bt + ((size_t)u.pn * 256 + lr) * K + lk;
        for (int k0 = 0; k0 < K; k0 += 16) {
            const u32x4 av = *(const u32x4*)(ap + k0), bv = *(const u32x4*)(bp + k0);
            __syncthreads();
            As[(lk + 0) * LDG + lr] = bflo(av.x); As[(lk + 1) * LDG + lr] = bfhi(av.x); As[(lk + 2) * LDG + lr] = bflo(av.y); As[(lk + 3) * LDG + lr] = bfhi(av.y);
            As[(lk + 4) * LDG + lr] = bflo(av.z); As[(lk + 5) * LDG + lr] = bfhi(av.z); As[(lk + 6) * LDG + lr] = bflo(av.w); As[(lk + 7) * LDG + lr] = bfhi(av.w);
            Bs[(lk + 0) * LDG + lr] = bflo(bv.x); Bs[(lk + 1) * LDG + lr] = bfhi(bv.x); Bs[(lk + 2) * LDG + lr] = bflo(bv.y); Bs[(lk + 3) * LDG + lr] = bfhi(bv.y);
            Bs[(lk + 4) * LDG + lr] = bflo(bv.z); Bs[(lk + 5) * LDG + lr] = bfhi(bv.z); Bs[(lk + 6) * LDG + lr] = bflo(bv.w); Bs[(lk + 7) * LDG + lr] = bfhi(bv.w);
            __syncthreads();
#pragma unroll 4
            for (int k = 0; k < 16; ++k) {
                float a[8];
#pragma unroll
                for (int i = 0; i < 8; ++i) a[i] = As[k * LDG + ty + 32 * i];
                const f32x4 b00 = *(const LAS f32x4*)(Bs + k * LDG + 8 * tx), b01 = *(const LAS f32x4*)(Bs + k * LDG + 8 * tx + 4);
                const f32x4 b10 = *(const LAS f32x4*)(Bs + k * LDG + 128 + 8 * tx), b11 = *(const LAS f32x4*)(Bs + k * LDG + 128 + 8 * tx + 4);
                const float b0[8] = {b00.x, b00.y, b00.z, b00.w, b01.x, b01.y, b01.z, b01.w}, b1[8] = {b10.x, b10.y, b10.z, b10.w, b11.x, b11.y, b11.z, b11.w};
#pragma unroll
                for (int i = 0; i < 8; ++i)
#pragma unroll
                    for (int j = 0; j < 8; ++j) { acc0[i][j] += a[i] * b0[j]; acc1[i][j] += a[i] * b1[j]; }
            }
        }
#pragma unroll
        for (int i = 0; i < 8; ++i) { const int row = u.pm * 256 + ty + 32 * i;
            if constexpr (Epi::GLU) E.glu(row, u.pj * 128 + 8 * tx, acc0[i], acc1[i]);
            else { E.store(row, u.pj * 256 + 8 * tx, acc0[i]); E.store(row, u.pj * 256 + 128 + 8 * tx, acc1[i]); } }
    }
    __syncthreads();
}

template <class Epi>
__device__ __forceinline__ void run_epi(const Epi& E, const f32x4 (&acc)[2][2][4][2], const Unit& u, int wr, int wc, int fr, int fq) {
    const int row0 = u.pm * BM + wr * 64 + fr;
    if constexpr (Epi::ROWCTX) {
        int dst[8]; float wv[8];
#pragma unroll
        for (int q = 0; q < 8; ++q) E.rowctx(row0 + (q >> 2) * HALF + (q & 3) * 16, dst[q], wv[q]);
#pragma unroll
        for (int ai = 0; ai < 2; ++ai)
#pragma unroll
            for (int m = 0; m < 4; ++m)
#pragma unroll
                for (int bj = 0; bj < 2; ++bj) { const f32x4 v0 = acc[ai][bj][m][0], v1 = acc[ai][bj][m][1];
                    const float v[8] = {v0.x, v0.y, v0.z, v0.w, v1.x, v1.y, v1.z, v1.w};
                    E.store_ctx(dst[ai * 4 + m], wv[ai * 4 + m], u.pj * 256 + bj * HALF + wc * 32 + 8 * fq, v); }
        return;
    }
    if constexpr (Epi::COLCTX) {
        float cc[2][8];
#pragma unroll
        for (int bj = 0; bj < 2; ++bj) E.colctx(row0, u.pj * 256 + bj * HALF + wc * 32 + 8 * fq, cc[bj]);
#pragma unroll
        for (int ai = 0; ai < 2; ++ai) {
            f32x4 bs[4][2][2];
            if constexpr (Epi::BASE) {
#pragma unroll
                for (int m = 0; m < 4; ++m)
#pragma unroll
                    for (int bj = 0; bj < 2; ++bj) E.loadbase(row0 + ai * HALF + m * 16, u.pj * 256 + bj * HALF + wc * 32 + 8 * fq, bs[m][bj]);
            }
#pragma unroll
            for (int m = 0; m < 4; ++m)
#pragma unroll
                for (int bj = 0; bj < 2; ++bj) { const f32x4 v0 = acc[ai][bj][m][0], v1 = acc[ai][bj][m][1];
                    const float v[8] = {v0.x, v0.y, v0.z, v0.w, v1.x, v1.y, v1.z, v1.w}; const int row = row0 + ai * HALF + m * 16, col = u.pj * 256 + bj * HALF + wc * 32 + 8 * fq;
                    if constexpr (Epi::BASE) E.store_cb(row, col, v, cc[bj], bs[m][bj]); else E.store_cc(row, col, v, cc[bj]); }
        }
        return;
    }
#pragma unroll
    for (int ai = 0; ai < 2; ++ai)
#pragma unroll
        for (int m = 0; m < 4; ++m) { const int row = row0 + ai * HALF + m * 16;
            if constexpr (Epi::GLU) {
                const f32x4 g0 = acc[ai][0][m][0], g1 = acc[ai][0][m][1], u0 = acc[ai][1][m][0], u1 = acc[ai][1][m][1];
                const float g[8] = {g0.x, g0.y, g0.z, g0.w, g1.x, g1.y, g1.z, g1.w}, uu[8] = {u0.x, u0.y, u0.z, u0.w, u1.x, u1.y, u1.z, u1.w};
                E.glu(row, u.pj * 128 + wc * 32 + 8 * fq, g, uu);
            } else {
#pragma unroll
                for (int bj = 0; bj < 2; ++bj) { const f32x4 v0 = acc[ai][bj][m][0], v1 = acc[ai][bj][m][1];
                    const float v[8] = {v0.x, v0.y, v0.z, v0.w, v1.x, v1.y, v1.z, v1.w};
                    E.store(row, u.pj * 256 + bj * HALF + wc * 32 + 8 * fq, v); }
            } }
}
template <class Epi, class Sched, bool ALIGN_EPI = true, bool GATHER = false>
__device__ __forceinline__ void gemm_fast(LAS unsigned char* lds, const bf16_t* Ag, const bf16_t* Btg, int K, const Sched& S, const Epi& E, const int* rowmap = nullptr) {
    const int tid = threadIdx.x, wid = __builtin_amdgcn_readfirstlane(tid >> 6), lane = tid & 63, wr = wid >> 2, wc = wid & 3, fr = lane & 15, fq = lane >> 4;
    const int nt = K / BK;
    unsigned voffB[2], vC[2][2], vN[2][2]; int RA[2], CA2[2];
#pragma unroll
    for (int i = 0; i < 2; ++i) { int R, C; stage_rc(tid * 16 + i * 8192, R, C); const int Rb = (R & ~31) + perm32(R & 31); RA[i] = R; CA2[i] = C * 2;
        voffB[i] = (unsigned)(Rb * K + C) * 2u;
#pragma unroll
        for (int h = 0; h < 2; ++h) { vC[h][i] = (unsigned)((h * HALF + R) * K + C) * 2u; vN[h][i] = vC[h][i]; } }
#define PG8_GATHER(v, u_) do { _Pragma("unroll") for (int h = 0; h < 2; ++h) _Pragma("unroll") for (int i = 0; i < 2; ++i) { const int d_ = rowmap[(u_).pm * BM + h * HALF + RA[i]]; \
        (v)[h][i] = (unsigned)((d_ < 0 ? 0 : (d_ >> 1)) * K) * 2u + (unsigned)CA2[i]; } } while (0)
    const size_t kstep = (size_t)(BK * 2);
    const size_t hstep = (size_t)HALF * K * 2;
    const size_t tstep = 2 * hstep;
    const unsigned ldsw = (unsigned)wid * 1024u;
    const int aoff = lds_byte(wr * 64 + fr, fq * 8), boff = lds_byte(wc * 32 + fr, fq * 8);
#define PG8_SA(b, h) (((b) * 2 + (h)) * HTB)
#define PG8_SB(b, h) ((4 + (b) * 2 + (h)) * HTB)
#define PG8_STAGE(bufoff, gbase, voff) do { _Pragma("unroll") for (int _i = 0; _i < 2; ++_i) \
        __builtin_amdgcn_global_load_lds((const unsigned*)((const char*)(gbase) + (voff)[_i]), (LAS unsigned*)(lds + (bufoff) + ldsw + _i * 8192), 16, 0, 0); } while (0)
#define PG8_LDA(dst, b, h) do { _Pragma("unroll") for (int m = 0; m < 4; ++m) _Pragma("unroll") for (int k = 0; k < 2; ++k) dst[m][k] = *(const LAS bf16x8*)(lds + PG8_SA(b, h) + aoff + m * 2048 + k * 1024); } while (0)
#define PG8_LDB(dst, b, h) do { _Pragma("unroll") for (int n = 0; n < 2; ++n) _Pragma("unroll") for (int k = 0; k < 2; ++k) dst[n][k] = *(const LAS bf16x8*)(lds + PG8_SB(b, h) + boff + n * 2048 + k * 1024); } while (0)
#define PG8_MMA(ai, bj, At, Bt) do { __builtin_amdgcn_s_setprio(1); _Pragma("unroll") for (int m = 0; m < 4; ++m) _Pragma("unroll") for (int n = 0; n < 2; ++n) _Pragma("unroll") for (int k = 0; k < 2; ++k) \
        acc[ai][bj][m][n] = __builtin_amdgcn_mfma_f32_16x16x32_bf16(Bt[n][k], At[m][k], acc[ai][bj][m][n], 0, 0, 0); __builtin_amdgcn_s_setprio(0); } while (0)
#define PG8_WAIT_V(n) asm volatile("s_waitcnt vmcnt(" #n ")" ::: "memory")
#define PG8_WAIT_L(n) asm volatile("s_waitcnt lgkmcnt(" #n ")" ::: "memory")
#define PG8_BAR __builtin_amdgcn_s_barrier()
#define PG8_SCHED __builtin_amdgcn_sched_barrier(0)
    Unit cur, nxt; int ui = 0;
    if (!S.next(0, cur)) return;
    f32x4 acc[2][2][4][2];
#pragma unroll
    for (int a = 0; a < 2; ++a)
#pragma unroll
        for (int b = 0; b < 2; ++b)
#pragma unroll
            for (int m = 0; m < 4; ++m)
#pragma unroll
                for (int n = 0; n < 2; ++n) acc[a][b][m][n] = (f32x4){0.f, 0.f, 0.f, 0.f};
    bf16x8 At[4][2], B0[2][2], B1[2][2];
    const char* cA = GATHER ? (const char*)Ag : (const char*)Ag + (size_t)cur.pm * tstep; const char* cB = (const char*)Btg + (size_t)cur.pn * tstep;
    if constexpr (GATHER) PG8_GATHER(vC, cur);
    PG8_STAGE(PG8_SB(0, 0), cB, voffB); PG8_STAGE(PG8_SB(0, 1), cB + hstep, voffB); PG8_STAGE(PG8_SA(0, 0), cA, vC[0]); PG8_STAGE(PG8_SA(0, 1), cA, vC[1]);
    if (wr == 1) PG8_BAR;
    PG8_WAIT_V(2); PG8_BAR;
    PG8_STAGE(PG8_SB(1, 0), cB + kstep, voffB); PG8_STAGE(PG8_SA(1, 0), cA + kstep, vC[0]); PG8_STAGE(PG8_SB(1, 1), cB + hstep + kstep, voffB);
    PG8_WAIT_V(6); PG8_BAR;
    for (;;) {
        const bool has_next = S.next(ui + 1, nxt);
        const char* nA = (has_next && !GATHER) ? (const char*)Ag + (size_t)nxt.pm * tstep : cA; const char* nB = has_next ? (const char*)Btg + (size_t)nxt.pn * tstep : cB;
        if constexpr (GATHER) { if (has_next) PG8_GATHER(vN, nxt); else { _Pragma("unroll") for (int h = 0; h < 2; ++h) _Pragma("unroll") for (int i = 0; i < 2; ++i) vN[h][i] = vC[h][i]; } }
        for (int t = 0; t < nt; t += 2) {
            const bool last = (t == nt - 2);
            const char* a1 = cA + (size_t)(t + 1) * kstep;
            const char* a2 = last ? nA : cA + (size_t)(t + 2) * kstep; const char* b2 = last ? nB : cB + (size_t)(t + 2) * kstep;
            const char* a3 = a2 + kstep; const char* b3 = b2 + kstep;
            unsigned vS[2][2];
#pragma unroll
            for (int h = 0; h < 2; ++h)
#pragma unroll
                for (int i = 0; i < 2; ++i) vS[h][i] = (GATHER && last) ? vN[h][i] : vC[h][i];
            PG8_LDB(B0, 0, 0); PG8_LDB(B1, 0, 1); PG8_SCHED; PG8_LDA(At, 0, 0); PG8_STAGE(PG8_SA(1, 1), a1, vC[1]);
            PG8_WAIT_V(8); PG8_WAIT_L(0); PG8_BAR; PG8_MMA(0, 0, At, B0); PG8_MMA(0, 1, At, B1); PG8_BAR; PG8_SCHED;
            PG8_LDA(At, 0, 1); PG8_STAGE(PG8_SB(0, 0), b2, voffB); PG8_STAGE(PG8_SB(0, 1), b2 + hstep, voffB); PG8_STAGE(PG8_SA(0, 0), a2, vS[0]);
            PG8_WAIT_V(8); PG8_WAIT_L(0); PG8_BAR; PG8_MMA(1, 0, At, B0); PG8_MMA(1, 1, At, B1); PG8_BAR; PG8_SCHED;
            PG8_LDB(B0, 1, 0); PG8_LDB(B1, 1, 1); PG8_SCHED; PG8_LDA(At, 1, 0); PG8_STAGE(PG8_SA(0, 1), a2, vS[1]);
            PG8_WAIT_V(8); PG8_WAIT_L(0); PG8_BAR; PG8_MMA(0, 0, At, B0); PG8_MMA(0, 1, At, B1); PG8_BAR; PG8_SCHED;
            PG8_LDA(At, 1, 1); PG8_STAGE(PG8_SB(1, 0), b3, voffB); PG8_STAGE(PG8_SB(1, 1), b3 + hstep, voffB); PG8_STAGE(PG8_SA(1, 0), a3, vS[0]);
            PG8_WAIT_V(8); PG8_WAIT_L(0); PG8_BAR; PG8_MMA(1, 0, At, B0); PG8_MMA(1, 1, At, B1); PG8_BAR; PG8_SCHED;
        }
        if constexpr (ALIGN_EPI) { if (wr == 0) PG8_BAR; }
        run_epi(E, acc, cur, wr, wc, fr, fq);
        if (!has_next) break;
#pragma unroll
        for (int a = 0; a < 2; ++a)
#pragma unroll
            for (int b = 0; b < 2; ++b)
#pragma unroll
                for (int m = 0; m < 4; ++m)
#pragma unroll
                    for (int n = 0; n < 2; ++n) acc[a][b][m][n] = (f32x4){0.f, 0.f, 0.f, 0.f};
        cur = nxt; cA = nA; cB = nB; ++ui;
        if constexpr (GATHER) { _Pragma("unroll") for (int h = 0; h < 2; ++h) _Pragma("unroll") for (int i = 0; i < 2; ++i) vC[h][i] = vN[h][i]; }
        if constexpr (ALIGN_EPI) { if (wr == 1) PG8_BAR; }
    }
    PG8_WAIT_V(0);
    if constexpr (!ALIGN_EPI) { if (wr == 0) PG8_BAR; }
    PG8_BAR;
#undef PG8_GATHER
#undef PG8_SA
#undef PG8_SB
#undef PG8_STAGE
#undef PG8_LDA
#undef PG8_LDB
#undef PG8_MMA
#undef PG8_WAIT_V
#undef PG8_WAIT_L
#undef PG8_BAR
#undef PG8_SCHED
}
template <bool ALIGN_EPI = true, bool GATHER = false, class Epi, class Sched>
__device__ __forceinline__ void gemm_run(LAS unsigned char* lds, const bf16_t* A, const bf16_t* Bt, int K, const Sched& S, const Epi& E, const int* rowmap = nullptr) {
#if GOLD_GEMM
    gemm_gold<GATHER>(lds, A, Bt, K, S, E, rowmap);
#else
    gemm_fast<Epi, Sched, ALIGN_EPI, GATHER>(lds, A, Bt, K, S, E, rowmap);
#endif
}

__device__ __forceinline__ void cvt_tile(LAS float* tl, const float* s0, const float* s1, int ld, bf16_t* dst, int K, int tid) {
    constexpr int LDW = 257;
    const int c4 = tid & 63, r0 = tid >> 6;
    const float* sp = (c4 < 32 ? s0 : s1) + 4 * (c4 & 31);
    f32x4 v[8];
#pragma unroll
    for (int p = 0; p < 8; ++p) v[p] = *(const f32x4*)(sp + (size_t)(p * 8 + r0) * ld);
#pragma unroll
    for (int p = 0; p < 8; ++p) { LAS float* q = tl + (p * 8 + r0) * LDW + 4 * c4; q[0] = v[p].x; q[1] = v[p].y; q[2] = v[p].z; q[3] = v[p].w; }
    __syncthreads();
    const int ch = tid & 7, n0 = tid >> 3;
#pragma unroll
    for (int p = 0; p < 4; ++p) { const int n = p * 64 + n0; const LAS float* s = tl + (8 * ch) * LDW + n;
        u32x4 o; o.x = pk2(s[0], s[LDW]); o.y = pk2(s[2 * LDW], s[3 * LDW]); o.z = pk2(s[4 * LDW], s[5 * LDW]); o.w = pk2(s[6 * LDW], s[7 * LDW]);
        __builtin_nontemporal_store(o, (u32x4*)(dst + (size_t)n * K + 8 * ch)); }
    __syncthreads();
}
__device__ __forceinline__ void ph_pre(const Ctx& C) {
    for (int i = C.bid * NTHREADS + C.tid; i < 2 * D; i += C.nb * NTHREADS) {
        const int d = i / D, cc = i % D;
        const float a0 = C.hlb[(d * 3 + 0) * D + cc], a1 = C.hlb[(d * 3 + 1) * D + cc], a2 = C.hlb[(d * 3 + 2) * D + cc];
        const float m = fmaxf(a0, fmaxf(a1, a2)); const float e0 = __expf(a0 - m), e1 = __expf(a1 - m), e2 = __expf(a2 - m);
        C.lbt[i] = e0 / (e0 + e1 + e2);
    }
    LAS float* sl = (LAS float*)C.lds;
    constexpr int N_ADA = 384, N_CVT = 1280 + 256 + 512 + 256;
    for (int t = C.bid; t < N_ADA + N_CVT; t += C.nb) {
        int tid = C.tid; asm volatile("" : "+v"(tid));
        if (t < N_ADA) {
            const int l = t / 192, rem = t % 192, ks = rem / 6, cb = rem % 6;
            for (int i = tid; i < 9 * 64; i += NTHREADS) { const int r = i >> 6, kk = i & 63; const float v = r < 8 ? C.c[r * D + ks * 64 + kk] : C.c_ctx[ks * 64 + kk]; sl[i] = silu(v); }
            __syncthreads();
            const int n = (cb * 512 + tid) * 4;
            f32x4 acc[9];
#pragma unroll
            for (int r = 0; r < 9; ++r) acc[r] = (f32x4){0.f, 0.f, 0.f, 0.f};
            const float* wp = C.ada_w + ((size_t)l * D + ks * 64) * (6 * D) + n;
#pragma unroll 8
            for (int kk = 0; kk < 64; ++kk) { const f32x4 w = *(const f32x4*)(wp + (size_t)kk * 6 * D);
#pragma unroll
                for (int r = 0; r < 9; ++r) acc[r] += sl[r * 64 + kk] * w; }
#pragma unroll
            for (int r = 0; r < 9; ++r) *(f32x4*)(C.modp + ((size_t)(l * 32 + ks) * 9 + r) * (6 * D) + n) = acc[r];
            __syncthreads();
        } else {
            int r = t - N_ADA;
            if (r < 1280) { const int nt = r / 32, kt = r % 32; const float* s = C.w_in + (size_t)(64 * kt) * 10240 + 256 * nt;
                cvt_tile(sl, s, s + 128, 10240, C.Win + (size_t)(256 * nt) * D + 64 * kt, D, tid); continue; } r -= 1280;
            if (r < 256) { const int nt = r / 32, kt = r % 32; const float* s = C.w_out + (size_t)(64 * kt) * D + 256 * nt;
                cvt_tile(sl, s, s + 128, D, C.Wout + (size_t)(256 * nt) * D + 64 * kt, D, tid); continue; } r -= 256;
            if (r < 512) { const int nt = r / 32, kt = r % 32; const float* s = C.pw1 + (size_t)(64 * kt) * 4096 + 128 * nt;
                cvt_tile(sl, s, s + 2048, 4096, C.Wpw1 + (size_t)(256 * nt) * D + 64 * kt, D, tid); continue; } r -= 512;
            if (r < 256) { const int nt = r / 32, kt = r % 32; const float* s = C.pw2 + (size_t)(64 * kt) * D + 256 * nt;
                cvt_tile(sl, s, s + 128, D, C.Wpw2 + (size_t)(256 * nt) * D + 64 * kt, D, tid); continue; }
        }
    }
}
__device__ __forceinline__ void cvt_moe_task(const Ctx& C, int r, const float*& src, int& ld, bf16_t*& dst, int& K, int tid) {
    r = r < 24576 ? r : 24575;
    const int c4 = tid & 63, r0 = tid >> 6; const int ly = r / 12288, jj = r - ly * 12288;
    const bool gu = jj < 8192; const int r2 = gu ? ly * 8192 + jj : ly * 4096 + (jj - 8192);
    const int le = gu ? (r2 >> 7) : (r2 >> 6), q = gu ? (r2 & 127) : (r2 & 63), nt = gu ? (q >> 5) : (q >> 3), kt = gu ? (q & 31) : (q & 7);
    const float* sg = (c4 < 32 ? C.wg : C.wu) + (size_t)le * D * MHID + (size_t)(64 * kt + r0) * MHID + 128 * nt + 4 * (c4 & 31);
    const float* sd = C.wd + (size_t)le * MHID * D + (size_t)(64 * kt + r0) * D + 256 * nt + (c4 < 32 ? 0 : 128) + 4 * (c4 & 31);
    src = gu ? sg : sd; ld = gu ? MHID : D; K = gu ? D : MHID;
    dst = gu ? C.Wgu + ((size_t)le * 1024 + 256 * nt) * D + 64 * kt : C.Wd + ((size_t)le * D + 256 * nt) * MHID + 64 * kt;
}
__device__ __forceinline__ void cvt_issue(const Ctx& C, int r, f32x4 (&v)[8], int tid) {
    const float* src; int ld, K; bf16_t* dst; cvt_moe_task(C, r, src, ld, dst, K, tid);
#pragma unroll
    for (int p = 0; p < 8; ++p) v[p] = __builtin_nontemporal_load((const f32x4*)(src + (size_t)(p * 8) * ld));
}
__device__ __forceinline__ void cvt_to_lds(LAS float* tl, const f32x4 (&v)[8], int tid) {
    const int c4 = tid & 63, r0 = tid >> 6;
#pragma unroll
    for (int p = 0; p < 8; ++p) *(LAS f32x4*)((LAS char*)tl + (p * 8 + r0) * 1024 + ((c4 ^ p) << 4)) = v[p];
}
__device__ __forceinline__ void cvt_store(const Ctx& C, int r, const LAS float* tl, int tid) {
    const float* src; int ld, K; bf16_t* dst; cvt_moe_task(C, r, src, ld, dst, K, tid);
    const int ch = tid & 7, n0 = tid >> 3;
#pragma unroll
    for (int p = 0; p < 4; ++p) { const int n = p * 64 + n0; const LAS float* sp = (const LAS float*)((const LAS char*)tl + (8 * ch) * 1024 + (((n >> 2) ^ ch) << 4) + (n & 3) * 4);
        u32x4 o; o.x = pk2(sp[0], sp[256]); o.y = pk2(sp[2 * 256], sp[3 * 256]); o.z = pk2(sp[4 * 256], sp[5 * 256]); o.w = pk2(sp[6 * 256], sp[7 * 256]);
        __builtin_nontemporal_store(o, (u32x4*)(dst + (size_t)n * K + 8 * ch)); }
}
template <int COUNT>
__device__ __forceinline__ void ph_cvt_moe_fixed(const Ctx& C, int first, int stride) {
    LAS float* tl = (LAS float*)C.lds;
    int tid = C.tid; asm volatile("" : "+v"(tid));
    f32x4 v0[8], v1[8], v2[8], v3[8];
    cvt_issue(C, first, v0, tid); cvt_issue(C, first + stride, v1, tid); cvt_issue(C, first + 2 * stride, v2, tid); cvt_issue(C, first + 3 * stride, v3, tid);
#define CVT_STEP(v, jj) { LAS float* tb = tl + ((jj) & 1) * 16384; cvt_to_lds(tb, v, tid); __syncthreads(); { const int jn = (jj) + 4 < COUNT ? (jj) + 4 : COUNT - 1; cvt_issue(C, first + jn * stride, v, tid); } \
        cvt_store(C, first + (jj) * stride, tb, tid); }
#pragma unroll
    for (int j = 0; j < COUNT; j += 4) { CVT_STEP(v0, j) CVT_STEP(v1, j + 1) CVT_STEP(v2, j + 2) CVT_STEP(v3, j + 3) }
#undef CVT_STEP
    __syncthreads();
}
__device__ __forceinline__ int idle_quota(int nblk, int nN, int per) { const int rem = (nblk * nN) & 255; return rem ? per * (256 - rem) : 0; }
template <int PER>
__device__ __forceinline__ void cvt_in_tail(const Ctx& C, int nblk, int nN, int base) {
    const int rem = (nblk * nN) & 255;
    if (rem != 0 && C.vc >= rem) ph_cvt_moe_fixed<PER>(C, 12288 + base + (C.vc - rem), 256 - rem);
}
__device__ __forceinline__ void ph_cvt_moe(const Ctx& C, int first, int count, int stride) {
    if (count == 48) { ph_cvt_moe_fixed<48>(C, first, stride); return; }
    if (count == 44) { ph_cvt_moe_fixed<44>(C, first, stride); return; }
    if (count == 40) { ph_cvt_moe_fixed<40>(C, first, stride); return; }
    if (count == 36) { ph_cvt_moe_fixed<36>(C, first, stride); return; }
    if (count == 32) { ph_cvt_moe_fixed<32>(C, first, stride); return; }
    LAS float* tl = (LAS float*)C.lds;
    if (count < 4) return;
    int tid = C.tid; asm volatile("" : "+v"(tid));
    f32x4 v0[8], v1[8], v2[8], v3[8];
    cvt_issue(C, first, v0, tid); cvt_issue(C, first + stride, v1, tid); cvt_issue(C, first + 2 * stride, v2, tid); cvt_issue(C, first + 3 * stride, v3, tid);
#define CVT_STEP(v, jj, par) { LAS float* tb = tl + (par) * 16384; cvt_to_lds(tb, v, tid); __syncthreads(); { const int jn = (jj) + 4 < count ? (jj) + 4 : count - 1; cvt_issue(C, first + jn * stride, v, tid); } \
        cvt_store(C, first + (jj) * stride, tb, tid); }
    for (int j = 0; j < count; j += 4) { CVT_STEP(v0, j, 0) CVT_STEP(v1, j + 1, 1) CVT_STEP(v2, j + 2, 0) CVT_STEP(v3, j + 3, 1) }
#undef CVT_STEP
    __syncthreads();
}
__device__ __forceinline__ void ph_modr(const Ctx& C) {
    constexpr int N4 = 6 * D / 4;
    for (int i = C.bid * NTHREADS + C.tid; i < 2 * 9 * N4; i += C.nb * NTHREADS) {
        const int l = i / (9 * N4), rem = i % (9 * N4), r = rem / N4, n4 = rem % N4;
        f32x4 s = *(const f32x4*)(C.ada_b + (size_t)l * 6 * D + 4 * n4);
        for (int ks = 0; ks < 32; ++ks) s += *(const f32x4*)(C.modp + ((size_t)(l * 32 + ks) * 9 + r) * (6 * D) + 4 * n4);
        *(f32x4*)(C.mod + (size_t)(l * 9 + r) * 6 * D + 4 * n4) = s;
    }
}
__device__ __forceinline__ float row_rstd(const f32x4 (&v)[8]) {
    float ss = 0.f;
#pragma unroll
    for (int j = 0; j < 8; ++j) ss += (v[j].x * v[j].x + v[j].y * v[j].y) + (v[j].z * v[j].z + v[j].w * v[j].w);
    return rsqrtf(wave_sum(ss) * (1.f / D) + EPS);
}
__device__ __forceinline__ void norm_mod(const f32x4 (&v)[8], f32x4 (&y)[8], const float* g, const float* shift, const float* scale, int lane) {
    const float rstd = row_rstd(v);
#pragma unroll
    for (int j = 0; j < 8; ++j) { const int col = j * 256 + lane * 4;
        const f32x4 gg = *(const f32x4*)(g + col), sh = *(const f32x4*)(shift + col), sc = *(const f32x4*)(scale + col);
        y[j] = (v[j] * rstd) * gg * (sc + 1.f) + sh; }
}
__device__ __forceinline__ f32x4 ld_bf16x4(const bf16_t* p) { const u32x2 w = *(const u32x2*)p; return (f32x4){bflo(w.x), bfhi(w.x), bflo(w.y), bfhi(w.y)}; }
__device__ __forceinline__ void store_row_bf16(const f32x4 (&y)[8], bf16_t* dst, int lane) {
#pragma unroll
    for (int j = 0; j < 8; ++j) *(u32x2*)(dst + j * 256 + lane * 4) = (u32x2){pk2(y[j].x, y[j].y), pk2(y[j].z, y[j].w)};
}
__device__ __forceinline__ const float* n1_src(const Ctx& C, int row) { return row < NT ? C.x + (size_t)row * D : C.ctxx + (size_t)(row - NT) * D; }
__device__ __forceinline__ void ph_n1_l0(const Ctx& C) {
    const int nw = C.nb * 8, per = (NR + nw - 1) / nw;
    int row = (C.bid * 8 + C.wave) * per; const int rend = row + per < NR ? row + per : NR;
    if (row >= rend) return;
    f32x4 vn[8], gsc[8], shf[8]; int rb = -1;
    { const float* src = n1_src(C, row);
#pragma unroll
      for (int j = 0; j < 8; ++j) vn[j] = *(const f32x4*)(src + j * 256 + C.lane * 4); }
    for (; row < rend; ++row) {
        f32x4 v[8], y[8];
#pragma unroll
        for (int j = 0; j < 8; ++j) v[j] = vn[j];
        { const int nr = row + 1 < rend ? row + 1 : row; const float* src = n1_src(C, nr);
#pragma unroll
          for (int j = 0; j < 8; ++j) vn[j] = *(const f32x4*)(src + j * 256 + C.lane * 4); }
        const int r = row < NT ? (row >> 11) : 8;
        if (r != rb) { rb = r; const float* shift = modptr(C, 0, r, 0); const float* scale = modptr(C, 0, r, 1);
#pragma unroll
            for (int j = 0; j < 8; ++j) { const int col = j * 256 + C.lane * 4; gsc[j] = *(const f32x4*)(C.n1g + col) * (*(const f32x4*)(scale + col) + 1.f); shf[j] = *(const f32x4*)(shift + col); } }
        const float rstd = row_rstd(v);
#pragma unroll
        for (int j = 0; j < 8; ++j) y[j] = (v[j] * rstd) * gsc[j] + shf[j];
        store_row_bf16(y, C.A + (size_t)row * D, C.lane);
    }
}
__device__ __forceinline__ void ph_scan_gold(const Ctx& C) {
    LAS float* qL = (LAS float*)C.lds; LAS float* kL = qL + 16 * 128; LAS float* vL = kL + 16 * 128; LAS float* part = vL + 16 * 128;
    const int vcol = C.tid & 127, kq = C.tid >> 7;
    for (int unit = C.bid; unit < NBATCH * NHEAD * 2; unit += C.nb) {
        const int dir = unit & 1, bh = unit >> 1, b = bh >> 4, h = bh & 15;
        const f16_t* kx = dir ? C.kb : C.kf; bf16_t* ob = dir ? C.obw : C.ofw;
        float S[32];
#pragma unroll
        for (int j = 0; j < 32; ++j) S[j] = 0.f;
        for (int g = 0; g < (CTXL + SEQ) / 16; ++g) {
            const bool lat = g >= CTXL / 16; const int gl = lat ? g - CTXL / 16 : g; const int len = lat ? SEQ : CTXL; const int rbase = lat ? b * SEQ : NT + b * CTXL;
            __syncthreads();
            for (int idx = C.tid; idx < 16 * 128; idx += NTHREADS) { const int tt = idx >> 7, kk = idx & 127; const int t = dir ? (len - 1 - (16 * gl + tt)) : 16 * gl + tt;
                const size_t o = (size_t)(rbase + t) * D + h * 128 + kk;
                kL[idx] = (float)kx[o]; vL[idx] = bf2f(C.vv[o]); if (lat) qL[idx] = bf2f(C.qs[o]); }
            __syncthreads();
            for (int tt = 0; tt < 16; ++tt) { const float vv = vL[tt * 128 + vcol]; float p = 0.f;
#pragma unroll
                for (int j = 0; j < 32; ++j) { const float kv = kL[tt * 128 + 32 * kq + j]; S[j] = (1.f - kv) * S[j] + kv * vv; if (lat) p += S[j] * qL[tt * 128 + 32 * kq + j]; }
                if (lat) part[(tt * 4 + kq) * 128 + vcol] = p; }
            if (lat) { __syncthreads();
                for (int idx = C.tid; idx < 16 * 128; idx += NTHREADS) { const int tt = idx >> 7, vc2 = idx & 127; const int t = dir ? (len - 1 - (16 * gl + tt)) : 16 * gl + tt;
                    const float o = (part[(tt * 4 + 0) * 128 + vc2] + part[(tt * 4 + 1) * 128 + vc2]) + (part[(tt * 4 + 2) * 128 + vc2] + part[(tt * 4 + 3) * 128 + vc2]);
                    ob[(size_t)(rbase + t) * D + h * 128 + vc2] = (bf16_t)f2bf(o); } }
        }
    }
    __syncthreads();
}
__device__ __forceinline__ int scan_row(int b, int dir, int c, int u) {
    const int pos = dir ? 63 - u : u;
    if (c < 4) return NT + b * CTXL + (dir ? 3 - c : c) * 64 + pos;
    return b * SEQ + (dir ? 31 - (c - 4) : (c - 4)) * 64 + pos;
}
__device__ __forceinline__ void ph_scan_fast(const Ctx& C) {
    LAS unsigned char* L = C.lds;
    constexpr int QT = 0, KT = 17408, KET = 34816, VT = 53248, PP = 71680, ST = 80896, TOT = 115712, ER = 119808, EL = 120320;
    const int lane = C.lane, w = C.wave, fr = lane & 15, fq = lane >> 4, cp = lane, sg = w;
    typedef _Float16 h2_t __attribute__((ext_vector_type(2)));
    for (int unit = C.bid; unit < NBATCH * NHEAD * 2; unit += C.nb) {
        const int dir = unit & 1, bh = unit >> 1, b = bh >> 4, h = bh & 15;
        const f16_t* kx = dir ? C.kb : C.kf; bf16_t* ob = dir ? C.obw : C.ofw;
        f32x4 S[8];
#pragma unroll
        for (int i = 0; i < 8; ++i) S[i] = (f32x4){0.f, 0.f, 0.f, 0.f};
        unsigned rq[8], rv[8]; h2_t rk[8];
        const unsigned lane_off = (unsigned)(h * 128 + 2 * cp) * 2u;
#define SCAN_ROWP(buf, c_, i_) ((const char*)(buf) + (size_t)__builtin_amdgcn_readfirstlane(scan_row(b, dir, (c_), 8 * sg + (i_))) * (D * 2) + lane_off)
#pragma unroll
        for (int i = 0; i < 8; ++i) { rk[i] = *(const h2_t*)SCAN_ROWP(kx, 0, i); rv[i] = *(const unsigned*)SCAN_ROWP(C.vv, 0, i); rq[i] = 0u; }
        for (int c = 0; c < 36; ++c) {
            const bool lat = c >= 4;
            float kk0[8], kk1[8], lp0[8], lp1[8];
            { float a0 = 1.f, a1 = 1.f;
#pragma unroll
              for (int i = 0; i < 8; ++i) { kk0[i] = (float)rk[i].x; kk1[i] = (float)rk[i].y; a0 *= 1.f - kk0[i]; a1 *= 1.f - kk1[i]; lp0[i] = a0; lp1[i] = a1; }
              *(LAS f32x2*)(L + TOT + sg * 512 + cp * 8) = (f32x2){a0, a1}; }
            if (c + 1 < 36) {
#pragma unroll
                for (int i = 0; i < 8; ++i) rk[i] = *(const h2_t*)SCAN_ROWP(kx, c + 1, i); }
            __syncthreads();
            { float pre0 = 1.f, pre1 = 1.f, R0 = 1.f, R1 = 1.f, L0 = 1.f, L1 = 1.f;
#pragma unroll
              for (int g = 0; g < 8; ++g) { const f32x2 t = *(const LAS f32x2*)(L + TOT + g * 512 + cp * 8);
                  if (g < sg) { pre0 *= t.x; pre1 *= t.y; } if (g < 4) { R0 *= t.x; R1 *= t.y; } L0 *= t.x; L1 *= t.y; }
              R0 = fmaxf(R0, 1e-30f); R1 = fmaxf(R1, 1e-30f);
              const float iR0 = __builtin_amdgcn_rcpf(R0), iR1 = __builtin_amdgcn_rcpf(R1);
              float ke0[8], ke1[8];
#pragma unroll
              for (int i = 0; i < 8; ++i) { const float pf0 = fmaxf(pre0 * lp0[i], 1e-30f), pf1 = fmaxf(pre1 * lp1[i], 1e-30f);
                  const float r0 = __builtin_amdgcn_rcpf(pf0), r1 = __builtin_amdgcn_rcpf(pf1);
                  { const int u = 8 * sg + i;
                      *(LAS unsigned*)(L + QT + u * 272 + cp * 4) = cvt_pk_bf16(bflo(rq[i]) * pf0 * iR0, bfhi(rq[i]) * pf1 * iR1);
                      *(LAS unsigned*)(L + KT + u * 272 + cp * 4) = cvt_pk_bf16(kk0[i] * r0 * R0, kk1[i] * r1 * R1); }
                  ke0[i] = kk0[i] * r0 * L0; ke1[i] = kk1[i] * r1 * L1; }
              *(LAS u32x4*)(L + KET + (2 * cp) * 144 + sg * 16) = (u32x4){cvt_pk_bf16(ke0[0], ke0[1]), cvt_pk_bf16(ke0[2], ke0[3]), cvt_pk_bf16(ke0[4], ke0[5]), cvt_pk_bf16(ke0[6], ke0[7])};
              *(LAS u32x4*)(L + KET + (2 * cp + 1) * 144 + sg * 16) = (u32x4){cvt_pk_bf16(ke1[0], ke1[1]), cvt_pk_bf16(ke1[2], ke1[3]), cvt_pk_bf16(ke1[4], ke1[5]), cvt_pk_bf16(ke1[6], ke1[7])};
              *(LAS u32x4*)(L + VT + (2 * cp) * 144 + sg * 16) = (u32x4){(rv[0] & 0xffffu) | (rv[1] << 16), (rv[2] & 0xffffu) | (rv[3] << 16), (rv[4] & 0xffffu) | (rv[5] << 16), (rv[6] & 0xffffu) | (rv[7] << 16)};
              *(LAS u32x4*)(L + VT + (2 * cp + 1) * 144 + sg * 16) = (u32x4){(rv[0] >> 16) | (rv[1] & 0xffff0000u), (rv[2] >> 16) | (rv[3] & 0xffff0000u), (rv[4] >> 16) | (rv[5] & 0xffff0000u), (rv[6] >> 16) | (rv[7] & 0xffff0000u)};
              if (sg == 0) { *(LAS f32x2*)(L + ER + cp * 8) = (f32x2){R0, R1}; *(LAS f32x2*)(L + EL + cp * 8) = (f32x2){L0, L1}; } }
            if (c + 1 < 36) {
#pragma unroll
                for (int i = 0; i < 8; ++i) { rv[i] = *(const unsigned*)SCAN_ROWP(C.vv, c + 1, i); if (c + 1 >= 4) rq[i] = *(const unsigned*)SCAN_ROWP(C.qs, c + 1, i); }
            }
            __syncthreads();
            if (lat) {
                { const int tj = w & 3, sp = w >> 2; bf16x8 bq[4], ak[2][4];
#pragma unroll
                  for (int ks = 0; ks < 4; ++ks) bq[ks] = *(const LAS bf16x8*)(L + QT + (16 * tj + fr) * 272 + ks * 64 + fq * 16);
#pragma unroll
                  for (int hh = 0; hh < 2; ++hh)
#pragma unroll
                      for (int ks = 0; ks < 4; ++ks) ak[hh][ks] = *(const LAS bf16x8*)(L + KT + (16 * (2 * sp + hh) + fr) * 272 + ks * 64 + fq * 16);
                  asm volatile("" ::: "memory");
#pragma unroll
                  for (int hh = 0; hh < 2; ++hh) { const int si = 2 * sp + hh; f32x4 acc = (f32x4){0.f, 0.f, 0.f, 0.f};
#pragma unroll
                      for (int ks = 0; ks < 4; ++ks) acc = __builtin_amdgcn_mfma_f32_16x16x32_bf16(ak[hh][ks], bq[ks], acc, 0, 0, 0);
                      { const int s0 = 16 * si + 4 * fq, tt = 16 * tj + fr; acc.x = (s0 + 0 <= tt) ? acc.x : 0.f; acc.y = (s0 + 1 <= tt) ? acc.y : 0.f; acc.z = (s0 + 2 <= tt) ? acc.z : 0.f; acc.w = (s0 + 3 <= tt) ? acc.w : 0.f; }
                      *(LAS u32x2*)(L + PP + (16 * tj + fr) * 144 + (16 * si + 4 * fq) * 2) = (u32x2){cvt_pk_bf16(acc.x, acc.y), cvt_pk_bf16(acc.z, acc.w)}; } }
                { const f32x4 er = *(const LAS f32x4*)(L + ER + (16 * w + 4 * fq) * 4);
#pragma unroll
                  for (int vt = 0; vt < 8; ++vt) { const f32x4 sv = S[vt] * er; *(LAS u32x2*)(L + ST + (16 * vt + fr) * 272 + (16 * w + 4 * fq) * 2) = (u32x2){cvt_pk_bf16(sv.x, sv.y), cvt_pk_bf16(sv.z, sv.w)}; } }
                __syncthreads();
                { bf16x8 av[2], as4[4], fb[2][6];
#pragma unroll
                  for (int ks = 0; ks < 2; ++ks) av[ks] = *(const LAS bf16x8*)(L + VT + (16 * w + fr) * 144 + ks * 64 + fq * 16);
#pragma unroll
                  for (int ks = 0; ks < 4; ++ks) as4[ks] = *(const LAS bf16x8*)(L + ST + (16 * w + fr) * 272 + ks * 64 + fq * 16);
#define SCAN_LDC(buf, tj_) { _Pragma("unroll") for (int ks = 0; ks < 2; ++ks) fb[buf][ks] = *(const LAS bf16x8*)(L + PP + (16 * (tj_) + fr) * 144 + ks * 64 + fq * 16); \
                             _Pragma("unroll") for (int ks = 0; ks < 4; ++ks) fb[buf][2 + ks] = *(const LAS bf16x8*)(L + QT + (16 * (tj_) + fr) * 272 + ks * 64 + fq * 16); }
                  SCAN_LDC(0, 0)
#pragma unroll
                  for (int tj = 0; tj < 4; ++tj) { if (tj + 1 < 4) SCAN_LDC((tj + 1) & 1, tj + 1)
                      asm volatile("" ::: "memory");
                      f32x4 o = (f32x4){0.f, 0.f, 0.f, 0.f};
#pragma unroll
                      for (int ks = 0; ks < 2; ++ks) o = __builtin_amdgcn_mfma_f32_16x16x32_bf16(av[ks], fb[tj & 1][ks], o, 0, 0, 0);
#pragma unroll
                      for (int ks = 0; ks < 4; ++ks) o = __builtin_amdgcn_mfma_f32_16x16x32_bf16(as4[ks], fb[tj & 1][2 + ks], o, 0, 0, 0);
                      *(u32x2*)(ob + (size_t)scan_row(b, dir, c, 16 * tj + fr) * D + h * 128 + 16 * w + 4 * fq) = (u32x2){cvt_pk_bf16(o.x, o.y), cvt_pk_bf16(o.z, o.w)}; }
#undef SCAN_LDC
                }
            }
            { const f32x4 el = *(const LAS f32x4*)(L + EL + (16 * w + 4 * fq) * 4); bf16x8 ak[2], bv[2][8];
#pragma unroll
              for (int ks = 0; ks < 2; ++ks) ak[ks] = *(const LAS bf16x8*)(L + KET + (16 * w + fr) * 144 + ks * 64 + fq * 16);
#define SCAN_LDD(buf, v0_) { _Pragma("unroll") for (int q = 0; q < 4; ++q) _Pragma("unroll") for (int ks = 0; ks < 2; ++ks) bv[buf][2 * q + ks] = *(const LAS bf16x8*)(L + VT + (16 * ((v0_) + q) + fr) * 144 + ks * 64 + fq * 16); }
              SCAN_LDD(0, 0) SCAN_LDD(1, 4)
              asm volatile("" ::: "memory");
#pragma unroll
              for (int vt = 0; vt < 8; ++vt) { S[vt] = S[vt] * el;
#pragma unroll
                  for (int ks = 0; ks < 2; ++ks) S[vt] = __builtin_amdgcn_mfma_f32_16x16x32_bf16(ak[ks], bv[vt >> 2][2 * (vt & 3) + ks], S[vt], 0, 0, 0); }
#undef SCAN_LDD
            }
        }
        __syncthreads();
    }
}
__device__ __forceinline__ void ph_rdprep(const Ctx& C) {
    const int stride = C.nb * 8; int row = C.bid * 8 + C.wave;
    u32x4 an[4], bn[4], gn[4];
#define RD_LOAD(r_) do { const size_t ro_ = (size_t)(r_) * D + C.lane * 8; _Pragma("unroll") for (int j = 0; j < 4; ++j) { \
        an[j] = *(const u32x4*)(C.ofw + ro_ + j * 512); bn[j] = *(const u32x4*)(C.obw + ro_ + j * 512); gn[j] = *(const u32x4*)(C.gs + ro_ + j * 512); } } while (0)
    RD_LOAD(row < NT ? row : NT - 1);
    const f32x4 og0 = *(const f32x4*)(C.onorm + (C.lane & 15) * 8), og1 = *(const f32x4*)(C.onorm + (C.lane & 15) * 8 + 4);
    for (; row < NT; row += stride) {
        u32x4 a[4], b[4], g[4];
#pragma unroll
        for (int j = 0; j < 4; ++j) { a[j] = an[j]; b[j] = bn[j]; g[j] = gn[j]; }
        RD_LOAD(row + stride < NT ? row + stride : NT - 1);
#pragma unroll
        for (int j = 0; j < 4; ++j) {
            const float o0 = bflo(a[j].x) + bflo(b[j].x), o1 = bfhi(a[j].x) + bfhi(b[j].x), o2 = bflo(a[j].y) + bflo(b[j].y), o3 = bfhi(a[j].y) + bfhi(b[j].y);
            const float o4 = bflo(a[j].z) + bflo(b[j].z), o5 = bfhi(a[j].z) + bfhi(b[j].z), o6 = bflo(a[j].w) + bflo(b[j].w), o7 = bfhi(a[j].w) + bfhi(b[j].w);
            float ss = ((o0 * o0 + o1 * o1) + (o2 * o2 + o3 * o3)) + ((o4 * o4 + o5 * o5) + (o6 * o6 + o7 * o7));
#pragma unroll
            for (int o = 1; o < 16; o <<= 1) ss += __shfl_xor(ss, o);
            const float rstd = rsqrtf(ss * (1.f / HK) + EPS);
            u32x4 w;
            w.x = pk2(o0 * rstd * og0.x * bflo(g[j].x), o1 * rstd * og0.y * bfhi(g[j].x)); w.y = pk2(o2 * rstd * og0.z * bflo(g[j].y), o3 * rstd * og0.w * bfhi(g[j].y));
            w.z = pk2(o4 * rstd * og1.x * bflo(g[j].z), o5 * rstd * og1.y * bfhi(g[j].z)); w.w = pk2(o6 * rstd * og1.z * bflo(g[j].w), o7 * rstd * og1.w * bfhi(g[j].w));
            *(u32x4*)(C.A + (size_t)row * D + j * 512 + C.lane * 8) = w; }
    }
#undef RD_LOAD
}
__device__ __forceinline__ void ph_rprep(const Ctx& C) {
    for (int t = C.bid * 8 + C.wave; t < 2 * 8 * 80; t += C.nb * 8) {
        const int l = t / 640, rem = t % 640, b = rem / 80, n = rem % 80;
        const float* g2 = C.n2g + (size_t)l * D; const float* sh = modptr(C, l, b, 3); const float* sc = modptr(C, l, b, 4);
        const float* wsrc; int wstride; float bias0 = 0.f;
        if (n < 8) { wsrc = C.wr1 + (size_t)l * D * 8 + n; wstride = 8; bias0 = C.br1[l * 8 + n]; }
        else if (n < 72) { const int g = (n - 8) >> 3, e = (n - 8) & 7; wsrc = C.wr2 + ((size_t)(l * 8 + g) * D) * 8 + e; wstride = 8; bias0 = C.br2[(l * 8 + g) * 8 + e]; }
        else { wsrc = nullptr; wstride = 0; }
        bf16_t* oh = C.rwh + (size_t)(l * 8 + b) * 80 * D; bf16_t* ol = C.rwl + (size_t)(l * 8 + b) * 80 * D;
        float bs = 0.f;
#pragma unroll
        for (int j = 0; j < 8; ++j) { const int col = j * 256 + C.lane * 4; float wv[4];
#pragma unroll
            for (int e = 0; e < 4; ++e) wv[e] = wsrc ? wsrc[(size_t)(col + e) * wstride] : 0.f;
            const f32x4 gg = *(const f32x4*)(g2 + col), s4 = *(const f32x4*)(sc + col), h4 = *(const f32x4*)(sh + col);
            const float w0 = gg.x * (1.f + s4.x) * wv[0], w1 = gg.y * (1.f + s4.y) * wv[1], w2 = gg.z * (1.f + s4.z) * wv[2], w3 = gg.w * (1.f + s4.w) * wv[3];
            bs += (h4.x * wv[0] + h4.y * wv[1]) + (h4.z * wv[2] + h4.w * wv[3]);
            const unsigned p0 = cvt_pk_bf16(w0, w1), p1 = cvt_pk_bf16(w2, w3);
            const size_t fo = ((size_t)((col >> 5) * 5 + (n >> 4)) * 64 + ((col & 31) >> 3) * 16 + (n & 15)) * 8 + (col & 7);
            *(u32x2*)(oh + fo) = (u32x2){p0, p1};
            *(u32x2*)(ol + fo) = (u32x2){cvt_pk_bf16(w0 - bflo(p0), w1 - bfhi(p0)), cvt_pk_bf16(w2 - bflo(p1), w3 - bfhi(p1))}; }
        bs = wave_sum(bs);
        if (C.lane == 0) C.rbias[(l * 8 + b) * 80 + n] = bs + bias0;
    }
}
__device__ __forceinline__ void ph_n2r(const Ctx& C, int l, bool count = true) {
    for (int i = C.bid * NTHREADS + C.tid; i < MAXSLOT; i += C.nb * NTHREADS) C.slot_dst[i] = -1;
    LAS int* hist = (LAS int*)(C.lds + LDS_TAB + 1536);
    LAS float* lgp = (LAS float*)C.lds;
    LAS float* ssp = lgp + 4 * 64 * 80;
    LAS float* lg = ssp + 256;
    if (C.tid < 64) hist[C.tid] = 0;
    __syncthreads();
    const int fr = C.lane & 15, fq = C.lane >> 4;
    for (int rt = C.bid; rt < NT / 64; rt += C.nb) {
        const int rg = C.wave >> 2, kq = C.wave & 3;
        {
            const int r0 = rt * 64 + rg * 32, b = r0 >> 11;
            const bf16_t* hrow = C.H + (size_t)(r0 + fr) * D + 8 * fq + kq * 512;
            const unsigned wofs = (unsigned)__builtin_amdgcn_readfirstlane(((l * 8 + b) * 80 * D + kq * 16 * 5 * 512) * 2);
            const char* wh = (const char*)C.rwh + wofs; const char* wl = (const char*)C.rwl + wofs; const unsigned wlane = (unsigned)C.lane * 16u;
            f32x4 acc[2][5];
#pragma unroll
            for (int t = 0; t < 2; ++t)
#pragma unroll
                for (int nt = 0; nt < 5; ++nt) acc[t][nt] = (f32x4){0.f, 0.f, 0.f, 0.f};
            float ss[2] = {0.f, 0.f};
            bf16x8 hA[2], whA[5], wlA[5], hB[2], whB[5], wlB[5];
#define RT_LOAD(h_, wh_, wl_, kk) do { const int k_ = (kk) < 16 ? (kk) : 15; h_[0] = *(const bf16x8*)(hrow + 32 * k_); h_[1] = *(const bf16x8*)(hrow + 16 * D + 32 * k_); \
        _Pragma("unroll") for (int nt = 0; nt < 5; ++nt) { wh_[nt] = *(const bf16x8*)(wh + (size_t)((k_ * 5 + nt) * 1024) + wlane); wl_[nt] = *(const bf16x8*)(wl + (size_t)((k_ * 5 + nt) * 1024) + wlane); } } while (0)
#define RT_STEP(h_, wh_, wl_, kk) do { bf16x8 hc[2] = {h_[0], h_[1]}; bf16x8 whc[5], wlc[5]; _Pragma("unroll") for (int nt = 0; nt < 5; ++nt) { whc[nt] = wh_[nt]; wlc[nt] = wl_[nt]; } \
        RT_LOAD(h_, wh_, wl_, (kk) + 2); \
        _Pragma("unroll") for (int t = 0; t < 2; ++t) { const u32x4 hu = __builtin_bit_cast(u32x4, hc[t]); \
            const float h0 = bflo(hu.x), h1 = bfhi(hu.x), h2 = bflo(hu.y), h3 = bfhi(hu.y), h4 = bflo(hu.z), h5 = bfhi(hu.z), h6 = bflo(hu.w), h7 = bfhi(hu.w); \
            ss[t] += (h0 * h0 + h1 * h1) + (h2 * h2 + h3 * h3) + (h4 * h4 + h5 * h5) + (h6 * h6 + h7 * h7); } \
        _Pragma("unroll") for (int nt = 0; nt < 5; ++nt) _Pragma("unroll") for (int t = 0; t < 2; ++t) acc[t][nt] = __builtin_amdgcn_mfma_f32_16x16x32_bf16(whc[nt], hc[t], acc[t][nt], 0, 0, 0); \
        _Pragma("unroll") for (int nt = 0; nt < 5; ++nt) _Pragma("unroll") for (int t = 0; t < 2; ++t) acc[t][nt] = __builtin_amdgcn_mfma_f32_16x16x32_bf16(wlc[nt], hc[t], acc[t][nt], 0, 0, 0); } while (0)
            RT_LOAD(hA, whA, wlA, 0); RT_LOAD(hB, whB, wlB, 1);
#pragma unroll 1
            for (int ks = 0; ks < 16; ks += 2) { RT_STEP(hA, whA, wlA, ks); RT_STEP(hB, whB, wlB, ks + 1); }
#undef RT_LOAD
#undef RT_STEP
            __builtin_amdgcn_sched_barrier(0); asm volatile("s_nop 7\n\ts_nop 7" ::: "memory"); __builtin_amdgcn_sched_barrier(0);
#pragma unroll
            for (int t = 0; t < 2; ++t) { float sm = ss[t]; sm += __shfl_xor(sm, 16); sm += __shfl_xor(sm, 32);
              if (fq == 0) ssp[kq * 64 + rg * 32 + t * 16 + fr] = sm;
#pragma unroll
              for (int nt = 0; nt < 5; ++nt) *(LAS f32x4*)(lgp + (kq * 64 + rg * 32 + t * 16 + fr) * 80 + 16 * nt + 4 * fq) = acc[t][nt]; }
        }
        __syncthreads();
        { const float* rb = C.rbias + (l * 8 + ((rt * 64) >> 11)) * 80;
#pragma unroll 2
          for (int i = 0; i < 64 * 80 / NTHREADS; ++i) { const int idx = C.tid + i * NTHREADS, row = idx / 80, col = idx - row * 80;
              const float sm = (ssp[row] + ssp[64 + row]) + (ssp[128 + row] + ssp[192 + row]);
              const float a = (lgp[row * 80 + col] + lgp[(64 + row) * 80 + col]) + (lgp[(128 + row) * 80 + col] + lgp[(192 + row) * 80 + col]);
              lg[row * 80 + col] = a * rsqrtf(sm * (1.f / D) + EPS) + rb[col]; } }
        __syncthreads();
        if (C.wave < 2 && C.lane < 32) {
                const LAS float* lr = lg + (C.wave * 32 + C.lane) * 80; const int row = rt * 64 + C.wave * 32 + C.lane;
                int grp = 0; float best = -3.0e38f; float p[8];
#pragma unroll
                for (int g = 0; g < 8; ++g) { p[g] = lr[g]; if (p[g] > best) { best = p[g]; grp = g; } }
                float den = 0.f;
#pragma unroll
                for (int g = 0; g < 8; ++g) den += __expf(p[g] - best);
                const float pg = 1.f / den;
                float q[8]; int i1 = 0; float m1 = -3.0e38f;
#pragma unroll
                for (int g = 0; g < 8; ++g) { q[g] = lr[8 + grp * 8 + g]; if (q[g] > m1) { m1 = q[g]; i1 = g; } }
                int i2 = 0; float m2 = -3.0e38f;
#pragma unroll
                for (int g = 0; g < 8; ++g) if (g != i1 && q[g] > m2) { m2 = q[g]; i2 = g; }
                const float e2 = __expf(m2 - m1), inv = 1.f / (1.f + e2);
                const int ea = grp * 8 + i1, eb = grp * 8 + i2;
                C.eid[row * 2] = ea; C.eid[row * 2 + 1] = eb; C.gwt[row * 2] = pg * inv; C.gwt[row * 2 + 1] = pg * e2 * inv;
                __hip_atomic_fetch_add(&hist[ea], 1, __ATOMIC_RELAXED, __HIP_MEMORY_SCOPE_WORKGROUP); __hip_atomic_fetch_add(&hist[eb], 1, __ATOMIC_RELAXED, __HIP_MEMORY_SCOPE_WORKGROUP);
        }
        {
            int ln = C.lane; asm volatile("" : "+v"(ln));
            const int rbeg = 8 * C.wave, rend = rbeg + 8;
            const int b = (rt * 64) >> 11;
            f32x4 gsc[8], shf[8];
            { const float* g = C.n2g + (size_t)l * D; const float* shift = modptr(C, l, b, 3); const float* scale = modptr(C, l, b, 4);
#pragma unroll
              for (int j = 0; j < 8; ++j) { const int col = j * 256 + ln * 4; gsc[j] = *(const f32x4*)(g + col) * (*(const f32x4*)(scale + col) + 1.f); shf[j] = *(const f32x4*)(shift + col); } }
            f32x4 vn[8];
#pragma unroll
            for (int j = 0; j < 8; ++j) vn[j] = ld_bf16x4(C.H + (size_t)(rt * 64 + rbeg) * D + j * 256 + ln * 4);
            for (int rr = rbeg; rr < rend; ++rr) {
                const int row = rt * 64 + rr;
                f32x4 v[8], y[8];
#pragma unroll
                for (int j = 0; j < 8; ++j) v[j] = vn[j];
                { const int nrow = rt * 64 + (rr + 1 < rend ? rr + 1 : rr);
#pragma unroll
                  for (int j = 0; j < 8; ++j) vn[j] = ld_bf16x4(C.H + (size_t)nrow * D + j * 256 + ln * 4); }
                const float rstd = row_rstd(v);
#pragma unroll
                for (int j = 0; j < 8; ++j) y[j] = (v[j] * rstd) * gsc[j] + shf[j];
                store_row_bf16(y, C.A + (size_t)row * D, ln);
            }
        }
    }
    __syncthreads();
    if (count && C.tid < 64 && hist[C.tid] != 0) atomicAdd(C.ctl + cw_cnt(l, 0, C.tid), (unsigned)hist[C.tid]);
}
__device__ __forceinline__ void moe_tables(const Ctx& C, int l) {
    LAS int* tab = (LAS int*)(C.lds + LDS_TAB); LAS int* pst = (LAS int*)(C.lds + LDS_TAB + 1024);
    __syncthreads();
    if (C.wave == 0) {
        const int e = C.lane; const int cnt = (int)C.ctl[cw_cnt(l, 0, e)]; const int nbk = (cnt + 255) >> 8;
        int incl = nbk;
#pragma unroll
        for (int o = 1; o < 64; o <<= 1) { const int t = __shfl_up(incl, o); if (C.lane >= o) incl += t; }
        const int start = incl - nbk;
        pst[e] = start * 256;
        for (int q = 0; q < nbk; ++q) if (start + q < MAXBLK) tab[1 + start + q] = e;
        if (C.lane == 63) tab[0] = incl < MAXBLK ? incl : MAXBLK; }
    __syncthreads();
}
__device__ __forceinline__ void ph_disp(const Ctx& C, int l) {
    moe_tables(C, l);
    const LAS int* pst = (const LAS int*)(C.lds + LDS_TAB + 1024);
    for (int grp = C.bid * 8 + C.wave; grp < NT / 8; grp += C.nb * 8) {
        int pos = 0;
        if (C.lane < 16) { const int tok = grp * 8 + (C.lane >> 1), k = C.lane & 1;
            const int e = C.eid[tok * 2 + k];
            pos = pst[e] + (int)atomicAdd(C.ctl + cw_cnt(l, 1, e), 1u);
            C.slot_dst[pos] = tok * 2 + k; C.slot_w[pos] = C.gwt[tok * 2 + k]; }
    }
}
struct RowRaw { u32x2 h[8]; u32x2 a[8], b[8]; };
__device__ __forceinline__ void load_raw(const Ctx& C, int row, RowRaw& R) {
    const bf16_t* z0 = C.zb + (size_t)row * 2 * D; const bf16_t* z1 = z0 + D;
#pragma unroll
    for (int j = 0; j < 8; ++j) { const int col = j * 256 + C.lane * 4; R.h[j] = *(const u32x2*)(C.H + (size_t)row * D + col); R.a[j] = *(const u32x2*)(z0 + col); R.b[j] = *(const u32x2*)(z1 + col); }
}
__device__ __forceinline__ void combine_raw(const f32x4 (&m5)[8], const RowRaw& R, f32x4 (&v)[8]) {
#pragma unroll
    for (int j = 0; j < 8; ++j) { const f32x4 h = (f32x4){bflo(R.h[j].x), bfhi(R.h[j].x), bflo(R.h[j].y), bfhi(R.h[j].y)}, g = m5[j]; const u32x2 a = R.a[j], bq = R.b[j];
        v[j] = (f32x4){h.x + g.x * (bflo(a.x) + bflo(bq.x)), h.y + g.y * (bfhi(a.x) + bfhi(bq.x)), h.z + g.z * (bflo(a.y) + bflo(bq.y)), h.w + g.w * (bfhi(a.y) + bfhi(bq.y))}; }
}
__device__ __forceinline__ void ph_cmb1(const Ctx& C) {
    const int nw = C.nb * 8, per = (NT + nw - 1) / nw;
    int row = (C.bid * 8 + C.wave) * per; const int rend = row + per < NT ? row + per : NT;
    if (row >= rend) return;
    f32x4 m5[8], gsc[8], shf[8]; int rb = -1;
    RowRaw Rn; load_raw(C, row, Rn);
    for (; row < rend; ++row) {
        RowRaw Rc = Rn; load_raw(C, row + 1 < rend ? row + 1 : row, Rn);
        const int b = row >> 11;
        if (b != rb) { rb = b; const float* gate = modptr(C, 0, b, 5); const float* shift = modptr(C, 1, b, 0); const float* scale = modptr(C, 1, b, 1);
#pragma unroll
            for (int j = 0; j < 8; ++j) { const int col = j * 256 + C.lane * 4; m5[j] = *(const f32x4*)(gate + col);
                gsc[j] = *(const f32x4*)(C.n1g + D + col) * (*(const f32x4*)(scale + col) + 1.f); shf[j] = *(const f32x4*)(shift + col); } }
        f32x4 v[8]; combine_raw(m5, Rc, v);
#pragma unroll
        for (int j = 0; j < 8; ++j) *(u32x2*)(C.H + (size_t)row * D + j * 256 + C.lane * 4) = (u32x2){pk2(v[j].x, v[j].y), pk2(v[j].z, v[j].w)};
        const float rstd = row_rstd(v);
#pragma unroll
        for (int j = 0; j < 8; ++j) { const f32x4 y = (v[j] * rstd) * gsc[j] + shf[j]; *(u32x2*)(C.A + (size_t)row * D + j * 256 + C.lane * 4) = (u32x2){pk2(y.x, y.y), pk2(y.z, y.w)}; }
    }
}
template <int N>
__device__ __forceinline__ void conv_line_lds(const Ctx& C, int base, int stride, int ch0) {
    LAS unsigned char* L = C.lds;
    int tid = C.tid; asm volatile("" : "+v"(tid));
#pragma unroll
    for (int it = 0; it < N * 128 / NTHREADS; ++it) { const int q = tid + it * NTHREADS, p = q >> 7, cc = q & 127;
        const u32x4 v = *(const u32x4*)(C.ub + (size_t)(base + p * stride) * D + ch0 + cc * 8);
        *(LAS u32x4*)(L + p * 2048 + cc * 16) = v; }
    __syncthreads();
    const int ch = ch0 + 2 * tid;
    float w0[31], w1[31];
#pragma unroll
    for (int j = 0; j < 31; ++j) { const f32x2 w = *(const f32x2*)(C.wdw + j * D + ch); w0[j] = w.x; w1[j] = w.y; }
    const f32x2 bb = *(const f32x2*)(C.bdw + ch);
#pragma unroll
    for (int blk = 0; blk < N / 8; ++blk) {
        const int i0 = blk * 8;
        float x0[38], x1[38];
#pragma unroll
        for (int q = 0; q < 38; ++q) { const int p = i0 - 15 + q; const bool ok = (p >= 0 && p < N); const int pc = ok ? p : 0;
            const unsigned w = *(const LAS unsigned*)(L + pc * 2048 + tid * 4); x0[q] = ok ? bflo(w) : 0.f; x1[q] = ok ? bfhi(w) : 0.f; }
        float a0[8], a1[8];
#pragma unroll
        for (int o = 0; o < 8; ++o) { a0[o] = bb.x; a1[o] = bb.y; }
#pragma unroll
        for (int j = 0; j < 31; ++j)
#pragma unroll
            for (int o = 0; o < 8; ++o) { a0[o] += w0[j] * x0[o + j]; a1[o] += w1[j] * x1[o + j]; }
#pragma unroll
        for (int o = 0; o < 8; ++o) *(unsigned*)(C.cvb + (size_t)(base + (i0 + o) * stride) * D + ch) = pk2(a0[o], a1[o]);
    }
    __syncthreads();
}
__device__ __forceinline__ void ph_conv(const Ctx& C) {
    for (int unit = C.bid; unit < 768; unit += C.nb) {
        if (unit < 256) { const int b = unit >> 5, r = unit & 31; conv_line_lds<64>(C, b * SEQ + r * 64, 1, 0); }
        else { const int uu = unit - 256, b = uu >> 6, c = uu & 63; conv_line_lds<32>(C, b * SEQ + c, 64, 1024); }
    }
}
__device__ __forceinline__ void ph_ln(const Ctx& C) {
    const int stride = C.nb * 8; int row = C.bid * 8 + C.wave;
    f32x4 g[8], bq[8]; u32x2 an[8];
#pragma unroll
    for (int j = 0; j < 8; ++j) { const int col = j * 256 + C.lane * 4; g[j] = *(const f32x4*)(C.lng + col); bq[j] = *(const f32x4*)(C.lnb + col);
        an[j] = *(const u32x2*)(C.cvb + (size_t)(row < NT ? row : NT - 1) * D + col); }
    for (; row < NT; row += stride) {
        f32x4 v[8]; float s = 0.f;
#pragma unroll
        for (int j = 0; j < 8; ++j) { const u32x2 a = an[j]; v[j] = (f32x4){bflo(a.x), bfhi(a.x), bflo(a.y), bfhi(a.y)}; s += (v[j].x + v[j].y) + (v[j].z + v[j].w); }
        { const int nr = row + stride < NT ? row + stride : row;
#pragma unroll
          for (int j = 0; j < 8; ++j) an[j] = *(const u32x2*)(C.cvb + (size_t)nr * D + j * 256 + C.lane * 4); }
        const float mean = wave_sum(s) * (1.f / D); float s2 = 0.f;
#pragma unroll
        for (int j = 0; j < 8; ++j) { v[j] = v[j] - mean; s2 += (v[j].x * v[j].x + v[j].y * v[j].y) + (v[j].z * v[j].z + v[j].w * v[j].w); }
        const float rstd = rsqrtf(wave_sum(s2) * (1.f / D) + EPS);
#pragma unroll
        for (int j = 0; j < 8; ++j) { const f32x4 y = v[j] * rstd * g[j] + bq[j];
            *(u32x2*)(C.A + (size_t)row * D + j * 256 + C.lane * 4) = (u32x2){pk2(silu(y.x), silu(y.y)), pk2(silu(y.z), silu(y.w))}; }
    }
}
__device__ __forceinline__ void ph_final(const Ctx& C) {
    const int nw = C.nb * 8, per = (NT + nw - 1) / nw;
    int row = (C.bid * 8 + C.wave) * per; const int rend = row + per < NT ? row + per : NT;
    if (row >= rend) return;
    f32x4 m5[8], fg[8]; int rb = -1;
#pragma unroll
    for (int j = 0; j < 8; ++j) fg[j] = *(const f32x4*)(C.fing + j * 256 + C.lane * 4);
    RowRaw Rn; load_raw(C, row, Rn);
    for (; row < rend; ++row) {
        RowRaw Rc = Rn; load_raw(C, row + 1 < rend ? row + 1 : row, Rn);
        const int b = row >> 11;
        if (b != rb) { rb = b; const float* gate = modptr(C, 1, b, 5);
#pragma unroll
            for (int j = 0; j < 8; ++j) m5[j] = *(const f32x4*)(gate + j * 256 + C.lane * 4); }
        f32x4 v[8]; combine_raw(m5, Rc, v);
        const float rstd = row_rstd(v);
#pragma unroll
        for (int j = 0; j < 8; ++j) *(f32x4*)(C.out + (size_t)row * D + j * 256 + C.lane * 4) = v[j] * rstd * fg[j];
    }
}

constexpr int NPHASE = 21;
struct Args { const float* in[26]; float* out; unsigned char* ws; int ph_lo, ph_hi; };
__global__ void __launch_bounds__(NTHREADS, 2) fwd(Args args) {
    extern __shared__ __attribute__((aligned(16))) unsigned char lds_raw[];
    Ctx C;
    C.lds = (LAS unsigned char*)lds_raw;
    C.tid = threadIdx.x; C.lane = C.tid & 63; C.wave = __builtin_amdgcn_readfirstlane(C.tid >> 6); C.bid = blockIdx.x; C.nb = gridDim.x;
    C.vc = (C.nb % 8 == 0) ? (C.bid % 8) * (C.nb / 8) + C.bid / 8 : C.bid;
    const float* const* in = args.in;
    C.x = in[0]; C.c = in[1]; C.ctxx = in[2]; C.c_ctx = in[3]; C.ada_w = in[4]; C.ada_b = in[5]; C.n1g = in[6]; C.n2g = in[7]; C.w_in = in[8]; C.hlb = in[9]; C.onorm = in[10]; C.w_out = in[11];
    C.pw1 = in[12]; C.wdw = in[13]; C.bdw = in[14]; C.lng = in[15]; C.lnb = in[16]; C.pw2 = in[17]; C.wr1 = in[18]; C.br1 = in[19]; C.wr2 = in[20]; C.br2 = in[21]; C.wg = in[22]; C.wu = in[23]; C.wd = in[24]; C.fing = in[25];
    C.out = args.out;
    unsigned char* ws = args.ws;
    C.ctl = (unsigned*)(ws + WS_CTL); C.mod = (float*)(ws + WS_MOD); C.lbt = (float*)(ws + WS_LB); C.rwh = (bf16_t*)(ws + WS_RWH); C.rwl = (bf16_t*)(ws + WS_RWL); C.rbias = (float*)(ws + WS_RBIAS);
    C.eid = (int*)(ws + WS_ROUTE); C.gwt = (float*)(ws + WS_ROUTE + 131072); C.slot_dst = (int*)(ws + WS_ROUTE + 262144); C.slot_w = (float*)(ws + WS_ROUTE + 262144 + 196608);
    C.modp = (float*)(ws + WS_MODP);
    C.Win = (bf16_t*)(ws + WS_WIN); C.Wout = (bf16_t*)(ws + WS_WOUT); C.Wpw1 = (bf16_t*)(ws + WS_WPW1); C.Wpw2 = (bf16_t*)(ws + WS_WPW2); C.Wgu = (bf16_t*)(ws + WS_WGU); C.Wd = (bf16_t*)(ws + WS_WD);
    C.H = (bf16_t*)(ws + WS_H); C.A = (bf16_t*)(ws + WS_A);
    C.qs = (bf16_t*)(ws + WS_QS); C.gs = (bf16_t*)(ws + WS_GS); C.vv = (bf16_t*)(ws + WS_VV); C.kf = (f16_t*)(ws + WS_KF); C.kb = (f16_t*)(ws + WS_KB); C.ofw = (bf16_t*)(ws + WS_OFW); C.obw = (bf16_t*)(ws + WS_OBW);
    C.Xg = (bf16_t*)(ws + WS_XG); C.Hb = (bf16_t*)(ws + WS_HB); C.zb = (bf16_t*)(ws + WS_ZB); C.ub = (bf16_t*)(ws + WS_UB); C.cvb = (bf16_t*)(ws + WS_CV);

    volatile LAS unsigned* misc = (volatile LAS unsigned*)(C.lds + LDS_MISC);
    if (C.tid < 4) misc[C.tid] = 0u;
    __syncthreads();
    const int lo = args.ph_lo, hi = args.ph_hi;
    XcdBarrier bar; bar.bar = C.ctl + CW_BAR; bar.x = 0; bar.st = misc;
    if (hi - lo > 1) bar = xcd_barrier_post(C.ctl + CW_BAR, misc);
#ifndef PH_MASK
#define PH_MASK 0xFFFFFFFFu
#endif
#define IN(k) (((PH_MASK >> (k)) & 1u) && lo <= (k) && (k) < hi)
#define SEAM(k) do { if (IN(k) && IN((k) + 1)) xcd_barrier(bar); } while (0)
#ifndef DUP_MASK
#define DUP_MASK 0u
#endif
#define DUP(k) ((DUP_MASK >> (k)) & 1u)

#if DIAG_CK
#define CK(slot, p, nb_) cksum(C, slot, p, nb_)
#else
#define CK(slot, p, nb_) do {} while (0)
#endif
#define PHASE(k, ...) do { if (IN(k)) { __VA_ARGS__; if (DUP(k)) { __syncthreads(); __VA_ARGS__; } } SEAM(k); } while (0)
    PHASE(0, ph_pre(C));
    PHASE(1, ph_modr(C));
    PHASE(2, { CK(1, C.mod, 2 * 9 * 6 * D * 4); ph_n1_l0(C); ph_rprep(C); });
    PHASE(3, { const int q = (11 * (C.bid & 7)) >> 3; EpiProj E{C.qs, C.gs, C.vv, C.kf, C.kb, C.lbt};
        { ProjSched S{C.nb, C.bid, 0, q}; gemm_run(C.lds, C.A, C.Win, D, S, E); }
        ph_cvt_moe(C, C.bid, 12288 / C.nb, C.nb);
        { ProjSched S{C.nb, C.bid, q, 11}; gemm_run(C.lds, C.A, C.Win, D, S, E); } });
#if GOLD_SCAN
    PHASE(4, ph_scan_gold(C));
#else
    PHASE(4, { CK(3, C.qs, (size_t)NT * D * 2); CK(25, C.gs, (size_t)NT * D * 2); CK(26, C.vv, (size_t)NR * D * 2); CK(27, C.kf, (size_t)NR * D * 2); CK(28, C.kb, (size_t)NR * D * 2); ph_scan_fast(C); });
#endif
    PHASE(5, { CK(4, C.ofw, (size_t)NT * D * 2); CK(29, C.obw, (size_t)NT * D * 2); ph_rdprep(C); });
    PHASE(6, { CK(5, C.A, (size_t)NT * D * 2); DenseSched S{64, 8, C.nb, C.bid}; EpiRes<false> E{C.x, C.H, modptr(C, 0, 0, 2)}; gemm_run(C.lds, C.A, C.Wout, D, S, E); });
    if (IN(7)) { CK(6, C.H, (size_t)NT * D * 2); ph_n2r(C, 0); if (DUP(7)) { __syncthreads(); ph_n2r(C, 0, false); } } SEAM(7);
    PHASE(8, { CK(7, C.A, (size_t)NT * D * 2); CK(30, C.eid, NT * 2 * 4); CK(31, C.gwt, NT * 2 * 4); ph_disp(C, 0); });
    PHASE(9, { moe_tables(C, 0); MoeSched S{(const LAS int*)(C.lds + LDS_TAB), 4, C.nb, C.vc, 0}; EpiSwiGLU E{C.Hb}; gemm_run<true, true>(C.lds, C.A, C.Wgu, D, S, E, C.slot_dst);
        if (C.nb == 256) { const int nblk = ((const LAS int*)(C.lds + LDS_TAB))[0]; cvt_in_tail<24>(C, nblk, 4, 0); } });
    PHASE(10, { moe_tables(C, 0); MoeSched S{(const LAS int*)(C.lds + LDS_TAB), 8, C.nb, C.vc, 0}; EpiDown E{C.zb, C.slot_dst, C.slot_w}; gemm_run(C.lds, C.Hb, C.Wd, MHID, S, E);
        if (C.nb == 256) { const int nblk = ((const LAS int*)(C.lds + LDS_TAB))[0]; cvt_in_tail<4>(C, nblk, 8, idle_quota(nblk, 4, 24)); } });
    PHASE(11, { CK(10, C.zb, (size_t)NT * 2 * D * 2); ph_cmb1(C); });
    PHASE(12, { CK(11, C.H, (size_t)NT * D * 2); CK(32, C.A, (size_t)NT * D * 2); const int q = (4 * (C.bid & 7)) >> 3; EpiConvGLU E{C.ub};
        { DenseSched S{64, 16, C.nb, C.bid, 0, q}; gemm_run(C.lds, C.A, C.Wpw1, D, S, E); }
        if (C.nb == 256) { moe_tables(C, 0); const int nblk = ((const LAS int*)(C.lds + LDS_TAB))[0]; const int done = idle_quota(nblk, 4, 24) + idle_quota(nblk, 8, 4);
            const int cnt = (((12288 - done + 255) >> 8) + 3) & ~3; ph_cvt_moe(C, 12288 + done + C.bid, cnt, 256); }
        else ph_cvt_moe(C, 12288 + C.bid, 12288 / C.nb, C.nb);
        { DenseSched S{64, 16, C.nb, C.bid, q, 4}; gemm_run(C.lds, C.A, C.Wpw1, D, S, E); } });
    PHASE(13, { CK(12, C.ub, (size_t)NT * D * 2); ph_conv(C); });
    PHASE(14, { CK(13, C.cvb, (size_t)NT * D * 2); ph_ln(C); });
    PHASE(15, { CK(14, C.A, (size_t)NT * D * 2); DenseSched S{64, 8, C.nb, C.bid}; EpiRes<true> E{C.H, C.H, modptr(C, 1, 0, 2)}; gemm_run(C.lds, C.A, C.Wpw2, D, S, E); });
    if (IN(16)) { CK(15, C.H, (size_t)NT * D * 2); ph_n2r(C, 1); if (DUP(16)) { __syncthreads(); ph_n2r(C, 1, false); } } SEAM(16);
    PHASE(17, { CK(16, C.A, (size_t)NT * D * 2); CK(33, C.eid, NT * 2 * 4); CK(34, C.gwt, NT * 2 * 4); ph_disp(C, 1); });
    PHASE(18, { moe_tables(C, 1); MoeSched S{(const LAS int*)(C.lds + LDS_TAB), 4, C.nb, C.vc, 64 * 4}; EpiSwiGLU E{C.Hb}; gemm_run<true, true>(C.lds, C.A, C.Wgu, D, S, E, C.slot_dst); });
    PHASE(19, { moe_tables(C, 1); MoeSched S{(const LAS int*)(C.lds + LDS_TAB), 8, C.nb, C.vc, 64 * 8}; EpiDown E{C.zb, C.slot_dst, C.slot_w}; gemm_run(C.lds, C.Hb, C.Wd, MHID, S, E); });
    PHASE(20, { CK(19, C.zb, (size_t)NT * 2 * D * 2); ph_final(C); });
#if DIAG_CK
    if (hi - lo > 1) {
        xcd_barrier(bar);
        CK(20, C.out, (size_t)NT * D * 4);
        xcd_barrier(bar);
        unsigned* st = (unsigned*)(args.ws + WS_STICKY);
        LAS unsigned* kbad = (LAS unsigned*)(C.lds + LDS_TAB + 2048);
        if (C.tid == 0) { unsigned bad = 0u;
            if (st[0] == 0x5EEDC0DEu) { const int pri[30] = {22, 23, 24, 1, 2, 21, 3, 25, 26, 27, 28, 4, 29, 5, 6, 7, 30, 31, 10, 11, 32, 12, 13, 14, 15, 16, 33, 34, 19, 20};
                for (int q = 29; q >= 0; --q) { const int k = pri[q]; if (st[1 + k] != C.ctl[CW_CK + k]) bad = (unsigned)k; } }
            kbad[0] = bad; }
        __syncthreads();
        const unsigned bad = kbad[0];
        if (bad) { const float f = 1.f + 0.02f * (float)bad;
            for (size_t i = (size_t)C.bid * NTHREADS + C.tid; i < (size_t)NT * D / 4; i += (size_t)C.nb * NTHREADS) { f32x4 v = ((f32x4*)C.out)[i]; ((f32x4*)C.out)[i] = v * f; } }
        xcd_barrier(bar);
        if (C.bid == 0 && C.tid < 64) { st[1 + C.tid] = C.ctl[CW_CK + C.tid]; if (C.tid == 0) st[0] = 0x5EEDC0DEu; }
    }
#endif
#undef PHASE
#undef IN
#undef SEAM
}

extern "C" void kernel_launch(void* const* d_in, const int* in_sizes, int n_in, void* d_out, int out_size, void* d_ws, size_t ws_size, hipStream_t stream) {
    static int grid = 0;
    if (grid == 0) {
        if (n_in != 26 || in_sizes[0] != NT * D || out_size != NT * D || ws_size < WS_END) { fprintf(stderr, "kernel_launch: unexpected shapes / workspace (n_in %d, ws %zu < %zu)\n", n_in, ws_size, (size_t)WS_END); grid = -1; return; }
        int dev = 0, cus = 0;
        if (hipGetDevice(&dev) != hipSuccess || hipDeviceGetAttribute(&cus, hipDeviceAttributeMultiprocessorCount, dev) != hipSuccess) { grid = -1; return; }
        if (hipFuncSetAttribute((const void*)fwd, hipFuncAttributeMaxDynamicSharedMemorySize, LDS_BYTES) != hipSuccess) { fprintf(stderr, "kernel_launch: hipFuncSetAttribute failed\n"); grid = -1; return; }
        int per_cu = 0;
        if (hipOccupancyMaxActiveBlocksPerMultiprocessor(&per_cu, (const void*)fwd, NTHREADS, LDS_BYTES) != hipSuccess || per_cu < 1) fprintf(stderr, "kernel_launch: occupancy query reports %d blocks per CU\n", per_cu);
        (void)hipGetLastError();
        grid = cus;
    }
    if (grid < 0) return;
    (void)hipMemsetAsync((char*)d_ws + WS_CTL, 0, 256 * 1024, stream);
    Args a{};
    for (int i = 0; i < 26; ++i) a.in[i] = (const float*)d_in[i];
    a.out = (float*)d_out; a.ws = (unsigned char*)d_ws;
#if MK_MULTI
    for (int k = 0; k < NPHASE; ++k) { a.ph_lo = k; a.ph_hi = k + 1; hipLaunchKernelGGL(fwd, dim3(grid), dim3(NTHREADS), LDS_BYTES, stream, a); }
#else
    a.ph_lo = 0; a.ph_hi = NPHASE;
    hipLaunchKernelGGL(fwd, dim3(grid), dim3(NTHREADS), LDS_BYTES, stream, a);
#endif
}
```
